# Optimizing an MI355X kernel written in HIP

```python
import math
import jax, jax.numpy as jnp
from jax import lax
import numpy as np

D_MODEL = 1024
BATCH = 8
SEQ = 8192
DEPTH = 1

CHUNK = 64
Q_BLOCK = 128
HEAD_DIM = 64
N_DIFF_HEADS = D_MODEL // (4 * HEAD_DIM)
ATTN_W = N_DIFF_HEADS * 2 * HEAD_DIM
ROPE_THETA = 10000.0
LRU_W = D_MODEL // 2
LRU_BLOCK = 64
N_LRU_BLOCKS = LRU_W // LRU_BLOCK
CONV_W = 4
LRU_C = 8.0
MIX_W = ATTN_W + LRU_W
IN_W = 3 * ATTN_W + 2 * LRU_W
N_EXPERTS = 32
TOP_K = 4
D_FF = D_MODEL
SWIGLU_ALPHA = 1.702
SWIGLU_LIMIT = 7.0
EXPERT_BLOCK = 256
NORM_EPS = 1e-6
SUBLN_EPS = 1e-5

kernel_name = "chunk_causal_hymba_diffattn_rglru_moe"


def rmsnorm(x, g, eps=NORM_EPS):
    xf = x.astype(jnp.float32)
    y = xf * lax.rsqrt(jnp.mean(xf * xf, axis=-1, keepdims=True) + eps)
    return (y * g.astype(jnp.float32)).astype(x.dtype)


def rope(x, pos):
    half = HEAD_DIM // 2
    inv = ROPE_THETA ** (-jnp.arange(half, dtype=jnp.float32) / half)
    ang = pos.astype(jnp.float32)[:, None] * inv[None, :]
    cos, sin = jnp.cos(ang), jnp.sin(ang)
    xf = x.astype(jnp.float32)
    x1, x2 = xf[..., :half], xf[..., half:]
    return jnp.concatenate([x1 * cos - x2 * sin, x2 * cos + x1 * sin], axis=-1).astype(x.dtype)


def lambda_init(layer_idx):
    return 0.8 - 0.6 * math.exp(-0.3 * layer_idx)


def diff_attention(q, k, v, lam):
    B, H2, S, d = q.shape
    H = H2 // 2
    scale = d ** -0.5
    outs = []
    for blk in range(S // Q_BLOCK):
        s0 = blk * Q_BLOCK
        s1 = s0 + Q_BLOCK
        qb, kb, vb = q[:, :, s0:s1], k[:, :, :s1], v[:, :, :s1]
        sc = jnp.einsum('bhqd,bhkd->bhqk', qb, kb, preferred_element_type=jnp.float32) * scale
        q_chunk = (s0 + jnp.arange(Q_BLOCK)) // CHUNK
        k_chunk = jnp.arange(s1) // CHUNK
        mask = k_chunk[None, :] <= q_chunk[:, None]
        p = jax.nn.softmax(jnp.where(mask, sc, -jnp.inf), axis=-1)
        p = p.reshape(B, H, 2, Q_BLOCK, s1)
        w = p[:, :, 0] - lam * p[:, :, 1]
        outs.append(jnp.einsum('bhqk,bhkd->bhqd', w.astype(v.dtype), vb))
    return jnp.concatenate(outs, axis=2)


def causal_conv(x, w, b):
    S = x.shape[1]
    xp = jnp.pad(x, ((0, 0), (CONV_W - 1, 0), (0, 0)))
    return sum(xp[:, j:j + S] * w[j] for j in range(CONV_W)) + b


def rg_lru(xr, w_a, b_a, w_x, b_x, lam):
    B, S, W = xr.shape
    xb = xr.reshape(B, S, N_LRU_BLOCKS, LRU_BLOCK)
    r = jax.nn.sigmoid(jnp.einsum('bsnc,ncd->bsnd', xb, w_a).reshape(B, S, W) + b_a)
    i = jax.nn.sigmoid(jnp.einsum('bsnc,ncd->bsnd', xb, w_x).reshape(B, S, W) + b_x)
    log_a = -LRU_C * r.astype(jnp.float32) * jax.nn.softplus(-lam.astype(jnp.float32))
    a = jnp.exp(log_a)
    u = jnp.sqrt(-jnp.expm1(2.0 * log_a)) * (i * xr).astype(jnp.float32)

    def combine(left, right):
        a_l, b_l = left
        a_r, b_r = right
        return a_l * a_r, a_r * b_l + b_r

    _, h = lax.associative_scan(combine, (a, u), axis=1)
    return h.astype(xr.dtype)


def moe(h, w_router, b_router, w1, b1, w2, b2):
    B, S, D = h.shape
    T = B * S
    A = T * TOP_K
    xf = h.reshape(T, D)
    logits = (xf @ w_router + b_router).astype(jnp.float32)
    top_val, top_idx = lax.top_k(logits, TOP_K)
    gates = jax.nn.softmax(top_val, axis=-1)
    flat_e = top_idx.reshape(A)
    flat_tok = jnp.arange(A, dtype=jnp.int32) // TOP_K
    order = jnp.argsort(flat_e)
    se, stok, sg = flat_e[order], flat_tok[order], gates.reshape(A)[order]
    counts = jnp.bincount(flat_e, length=N_EXPERTS)
    padded = (counts + EXPERT_BLOCK - 1) // EXPERT_BLOCK * EXPERT_BLOCK
    pend = jnp.cumsum(padded)
    pstart = pend - padded
    ustart = jnp.cumsum(counts) - counts
    dest = pstart[se] + (jnp.arange(A, dtype=jnp.int32) - ustart[se])
    n_blocks = -(-A // EXPERT_BLOCK) + N_EXPERTS
    R = n_blocks * EXPERT_BLOCK
    row_tok = jnp.zeros((R,), jnp.int32).at[dest].set(stok)
    row_g = jnp.zeros((R,), jnp.float32).at[dest].set(sg)
    block_e = jnp.minimum(jnp.searchsorted(pend, jnp.arange(n_blocks) * EXPERT_BLOCK, side='right'),
                          N_EXPERTS - 1)

    def expert_block(args):
        tok, e = args
        hu = xf[tok] @ w1[e] + b1[e]
        glu = jnp.minimum(hu[:, :D_FF], SWIGLU_LIMIT)
        lin = jnp.clip(hu[:, D_FF:], -SWIGLU_LIMIT, SWIGLU_LIMIT)
        act = glu * jax.nn.sigmoid(SWIGLU_ALPHA * glu) * (lin + 1.0)
        return act @ w2[e] + b2[e]

    y = lax.map(expert_block, (row_tok.reshape(n_blocks, EXPERT_BLOCK), block_e))
    y = y.reshape(R, D) * row_g[:, None].astype(y.dtype)
    out = jnp.zeros((T, D), h.dtype).at[row_tok].add(y)
    return out.reshape(B, S, D)


def setup_inputs(seed: int = 0) -> dict:
    key = jax.random.key(seed)
    ks = jax.random.split(key, 32)
    f32 = jnp.float32
    nrm = lambda k, shape, s: jax.random.normal(k, shape, f32) * s
    gain = lambda k, shape: 1.0 + 0.02 * jax.random.normal(k, shape, f32)
    L = DEPTH
    a0 = jax.random.uniform(ks[19], (L, LRU_W), f32, 0.9, 0.999)
    a_base = a0 ** (1.0 / LRU_C)
    lru_lambda = jnp.log(a_base) - jnp.log1p(-a_base)
    return {
        "x": nrm(ks[0], (BATCH, SEQ, D_MODEL), 1.0),
        "c": nrm(ks[1], (BATCH, D_MODEL), 1.0),
        "w_ada": nrm(ks[2], (L, D_MODEL, 6 * D_MODEL), 0.5 * D_MODEL ** -0.5),
        "b_ada": nrm(ks[3], (L, 6 * D_MODEL), 0.02),
        "norm1_g": gain(ks[4], (L, D_MODEL)),
        "w_in": nrm(ks[5], (L, D_MODEL, IN_W), D_MODEL ** -0.5),
        "q_norm_g": gain(ks[6], (L, HEAD_DIM)),
        "k_norm_g": gain(ks[7], (L, HEAD_DIM)),
        "lambda_q1": nrm(ks[8], (L, HEAD_DIM), 0.1),
        "lambda_k1": nrm(ks[9], (L, HEAD_DIM), 0.1),
        "lambda_q2": nrm(ks[10], (L, HEAD_DIM), 0.1),
        "lambda_k2": nrm(ks[11], (L, HEAD_DIM), 0.1),
        "subln_g": gain(ks[12], (L, 2 * HEAD_DIM)),
        "conv_w": nrm(ks[13], (L, CONV_W, LRU_W), 0.5),
        "conv_b": nrm(ks[14], (L, LRU_W), 0.01),
        "w_rg_a": nrm(ks[15], (L, N_LRU_BLOCKS, LRU_BLOCK, LRU_BLOCK), LRU_BLOCK ** -0.5),
        "b_rg_a": nrm(ks[16], (L, LRU_W), 0.01),
        "w_rg_x": nrm(ks[17], (L, N_LRU_BLOCKS, LRU_BLOCK, LRU_BLOCK), LRU_BLOCK ** -0.5),
        "b_rg_x": nrm(ks[18], (L, LRU_W), 0.01),
        "lru_lambda": lru_lambda,
        "w_out": nrm(ks[20], (L, MIX_W, D_MODEL), MIX_W ** -0.5),
        "norm2_g": gain(ks[21], (L, D_MODEL)),
        "w_router": nrm(ks[22], (L, D_MODEL, N_EXPERTS), D_MODEL ** -0.5),
        "b_router": nrm(ks[23], (L, N_EXPERTS), 0.01),
        "w_moe1": nrm(ks[24], (L, N_EXPERTS, D_MODEL, 2 * D_FF), D_MODEL ** -0.5),
        "b_moe1": nrm(ks[25], (L, N_EXPERTS, 2 * D_FF), 0.01),
        "w_moe2": nrm(ks[26], (L, N_EXPERTS, D_FF, D_MODEL), D_FF ** -0.5),
        "b_moe2": nrm(ks[27], (L, N_EXPERTS, D_MODEL), 0.01),
    }


def reference(x, c, w_ada, b_ada, norm1_g, w_in, q_norm_g, k_norm_g, lambda_q1, lambda_k1,
              lambda_q2, lambda_k2, subln_g, conv_w, conv_b, w_rg_a, b_rg_a, w_rg_x, b_rg_x,
              lru_lambda, w_out, norm2_g, w_router, b_router, w_moe1, b_moe1, w_moe2, b_moe2):
    B, S, D = x.shape
    pos = jnp.arange(S, dtype=jnp.int32)
    for l in range(DEPTH):
        mod = jax.nn.silu(c) @ w_ada[l] + b_ada[l]
        sh1, sc1, g1, sh2, sc2, g2 = [m[:, None, :] for m in jnp.split(mod, 6, axis=-1)]

        hn = rmsnorm(x, norm1_g[l]) * (1.0 + sc1) + sh1
        proj = hn @ w_in[l]
        q, k, v, xr, gr = jnp.split(
            proj, [ATTN_W, 2 * ATTN_W, 3 * ATTN_W, 3 * ATTN_W + LRU_W], axis=-1)

        q = rmsnorm(q.reshape(B, S, 2 * N_DIFF_HEADS, HEAD_DIM), q_norm_g[l])
        k = rmsnorm(k.reshape(B, S, 2 * N_DIFF_HEADS, HEAD_DIM), k_norm_g[l])
        q = rope(q.transpose(0, 2, 1, 3), pos)
        k = rope(k.transpose(0, 2, 1, 3), pos)
        v = v.reshape(B, S, N_DIFF_HEADS, 2 * HEAD_DIM).transpose(0, 2, 1, 3)
        lam_init = lambda_init(l)
        lam = (jnp.exp(jnp.sum(lambda_q1[l].astype(jnp.float32) * lambda_k1[l].astype(jnp.float32)))
               - jnp.exp(jnp.sum(lambda_q2[l].astype(jnp.float32) * lambda_k2[l].astype(jnp.float32)))
               + lam_init)
        att = diff_attention(q, k, v, lam)
        att = rmsnorm(att, subln_g[l], SUBLN_EPS) * (1.0 - lam_init)
        att = att.transpose(0, 2, 1, 3).reshape(B, S, ATTN_W)

        xc = causal_conv(xr, conv_w[l], conv_b[l])
        hr = rg_lru(xc, w_rg_a[l], b_rg_a[l], w_rg_x[l], b_rg_x[l], lru_lambda[l])
        rec = hr * jax.nn.gelu(gr, approximate=True)

        mix = jnp.concatenate([att, rec], axis=-1) @ w_out[l]
        x = x + g1 * mix

        hm = rmsnorm(x, norm2_g[l]) * (1.0 + sc2) + sh2
        x = x + g2 * moe(hm, w_router[l], b_router[l], w_moe1[l], b_moe1[l], w_moe2[l], b_moe2[l])
    return x
```

```cpp
#include <hip/hip_runtime.h>
#include <cstdio>
#include <cstdint>

#define LAS __attribute__((address_space(3)))
#define GAS __attribute__((address_space(1)))
typedef unsigned short bf16_t;
typedef short bf16x8 __attribute__((ext_vector_type(8)));
typedef float f32x4 __attribute__((ext_vector_type(4)));
typedef float f32x2 __attribute__((ext_vector_type(2)));
typedef unsigned u32x4 __attribute__((ext_vector_type(4)));
typedef unsigned u32x2 __attribute__((ext_vector_type(2)));

#ifndef MK_N_LAUNCHES
#define MK_N_LAUNCHES 1
#endif

constexpr int NB = 8, SEQ = 8192, DM = 1024, MTOK = NB * SEQ;
constexpr int INW = 2560, AW = 512;
constexpr int NEXP = 32, DFF = 1024;
constexpr int HR = MTOK * 4 + NEXP * 256;
constexpr int MAXT = HR / 256;
constexpr float C2 = 0.125f * 1.4426950408889634f;
constexpr int NPHASE = 11;
constexpr int N_LAUNCHES = MK_N_LAUNCHES;
constexpr int NWAVES = 8;

constexpr size_t MiB = 1u << 20;
constexpr size_t WS_CTL = 0, CTL_ZERO_BYTES = 1 * MiB;
constexpr size_t WS_MODP = 1 * MiB;
constexpr size_t WS_MODV = 3 * MiB;
constexpr size_t WS_ROPE = 4 * MiB;
constexpr size_t WS_SCAL = 6 * MiB;
constexpr size_t WS_WGT = 6 * MiB + 65536;
constexpr size_t WS_CARRY = 8 * MiB;
constexpr size_t WS_TOPI = 10 * MiB, WS_GATE = 11 * MiB, WS_POS = 12 * MiB;
constexpr size_t WS_ROWTOK = 13 * MiB, WS_ROWG = 15 * MiB;
constexpr size_t WS_TILE = 17 * MiB + 512 * 1024;
constexpr size_t WS_SS = 18 * MiB;
constexpr size_t WS_WRF = 22 * MiB + 512 * 1024;
constexpr size_t WS_WIN = 24 * MiB, WS_WOUT = 29 * MiB;
constexpr size_t WS_W2 = 32 * MiB, WS_W1 = 96 * MiB, WS_XN = 224 * MiB;
constexpr size_t WS_Q = 352 * MiB;
constexpr size_t WS_MIX = 672 * MiB;
constexpr size_t WS_ACT = 352 * MiB;
constexpr size_t WS_Y = 624 * MiB;
constexpr size_t WS_X1 = 888 * MiB;
constexpr size_t WS_HL = 888 * MiB, WS_PP = 952 * MiB;
constexpr size_t WS_END = 1024 * MiB;
static_assert(WS_ACT + (size_t)HR * 1024 <= WS_Y && WS_Y + (size_t)HR * 1024 <= WS_X1 && WS_X1 + (size_t)MTOK * DM * 2 <= WS_END && (size_t)HR * 4 <= 2 * MiB, "ws map");
constexpr int CW_BAR = 4096;
constexpr int CW_CNT = 16384;

constexpr int RING_BYTES = 131072;
constexpr int LDSCTL_OFF = RING_BYTES;
constexpr int LDS_TILE_OFF = RING_BYTES + 1024;
constexpr int LDS_ROWL_OFF = RING_BYTES + 6144;
constexpr int LDS_AUX_OFF = RING_BYTES + 8192;
constexpr int LDS_BYTES = 147456;

__device__ __forceinline__ unsigned cvt_pk_bf16(float lo, float hi) { unsigned r; asm volatile("v_cvt_pk_bf16_f32 %0, %1, %2" : "=v"(r) : "v"(lo), "v"(hi)); return r; }
typedef float f32x16 __attribute__((ext_vector_type(16)));
typedef short s16x4 __attribute__((ext_vector_type(4)));
typedef __bf16 bf16x2_t __attribute__((ext_vector_type(2)));
__device__ __forceinline__ unsigned cvtpk(float lo, float hi) { f32x2 v = {lo, hi}; bf16x2_t b = __builtin_convertvector(v, bf16x2_t); return __builtin_bit_cast(unsigned, b); }
__device__ __forceinline__ float bf2f(unsigned short h) { return __uint_as_float(((unsigned)h) << 16); }
__device__ __forceinline__ float bflo(unsigned w) { return __uint_as_float(w << 16); }
__device__ __forceinline__ float bfhi(unsigned w) { return __uint_as_float(w & 0xffff0000u); }
__device__ __forceinline__ float wave_sum(float v) {
#pragma unroll
    for (int o = 1; o < 64; o <<= 1) v += __shfl_xor(v, o);
    return v;
}
__device__ __forceinline__ float wave_max(float v) {
#pragma unroll
    for (int o = 1; o < 64; o <<= 1) v = fmaxf(v, __shfl_xor(v, o));
    return v;
}
__device__ __forceinline__ float sigmoidf_(float z) { return __builtin_amdgcn_rcpf(1.0f + __expf(-z)); }
#define LDS_WAIT() asm volatile("s_waitcnt lgkmcnt(0)" ::: "memory")
#define VM_WAIT() asm volatile("s_waitcnt vmcnt(0)" ::: "memory")

namespace pg8 {
constexpr int BM = 256, BK = 64, HALF = 128, HTB = HALF * BK * 2, STAGE_BYTES = 8 * HTB, NXCD = 8, WGM = 8;
__host__ __device__ __forceinline__ int lds_byte(int r, int c) { const int st = (r >> 4) * 2 + (c >> 5), rr = r & 15, cc = c & 31, ob = rr * 64 + cc * 2; return st * 1024 + (ob ^ (((ob >> 9) & 1) << 5)); }
__host__ __device__ __forceinline__ void stage_rc(int b, int& R, int& C) { const int st = b / 1024, sb = b % 1024, swz = sb ^ (((sb >> 9) & 1) << 5); R = (st >> 1) * 16 + swz / 64; C = (st & 1) * 32 + (swz % 64) / 2; }
__host__ __device__ __forceinline__ int perm32(int rho) { const int n = rho >> 4, i = rho & 15; return 8 * (i >> 2) + 4 * n + (i & 3); }

struct Unit { int pm, pn, e; const char* A; const char* B; const int* rows; };

struct StaticOrder {
    int nM, nN, nwg, G, c; const char* A; const char* Bt; size_t tstep;
    __device__ void init(int M, int N, int K, int G_, int c_, const void* A_, const void* Bt_) { nM = M / BM; nN = N / BM; nwg = nM * nN; G = G_; c = c_; A = (const char*)A_; Bt = (const char*)Bt_; tstep = (size_t)BM * K * 2; }
    __device__ bool next(int i, Unit& u) const {
        const long L = (long)i * G + c; if (L >= nwg) return false;
        int wgid = (int)L; { const int q = nwg / NXCD, r = nwg % NXCD, xcd = wgid % NXCD, off = wgid / NXCD; wgid = (xcd < r ? xcd * (q + 1) : r * (q + 1) + (xcd - r) * q) + off; }
        const int nig = WGM * nN, gid = wgid / nig, fm = gid * WGM, gsz = (nM - fm) < WGM ? (nM - fm) : WGM;
        u.pm = fm + ((wgid % nig) % gsz); u.pn = (wgid % nig) / gsz; u.e = 0; u.A = A + (size_t)u.pm * tstep; u.B = Bt + (size_t)u.pn * tstep; u.rows = nullptr; return true;
    }
    __device__ const float* aux0(const Unit&) const { return nullptr; }
    __device__ const float* aux1(const Unit&) const { return nullptr; }
};

typedef int i32x8 __attribute__((ext_vector_type(8)));
template <class Epi, class Sched, bool GATHER, bool ALIGN_EPI, bool F8 = false>
__device__ __forceinline__ void gemm_phase(LAS unsigned char* lds, const int K, const Sched& S, const Epi& E, LAS int* rowl = nullptr, LAS float* auxl = nullptr) {
    int tid_ = threadIdx.x; asm volatile("" : "+v"(tid_));
    const int tid = tid_, wid = __builtin_amdgcn_readfirstlane(tid >> 6), lane = tid & 63, wr = wid >> 2, wc = wid & 3, fr = lane & 15, fq = lane >> 4;
    const int nt = K / BK;
    const size_t kstep = (size_t)(BK * 2);
    const unsigned hstep = (unsigned)HALF * (unsigned)K * 2u;
    int Rr[2]; unsigned Cb[2]; unsigned vA[2], vB[2];
#pragma unroll
    for (int i = 0; i < 2; ++i) { int R, C; stage_rc(tid * 16 + i * 8192, R, C); const int Rb = Epi::PERM ? ((R & ~31) + perm32(R & 31)) : R;
        Rr[i] = R; Cb[i] = (unsigned)C * 2u; vA[i] = (unsigned)(R * K + C) * 2u; vB[i] = (unsigned)(Rb * K + C) * 2u; }
    const unsigned ldsw = (unsigned)wid * 1024u;
    const int aoff = lds_byte(wr * 64 + fr, fq * 8), boff = lds_byte(wc * 32 + fr, fq * 8);
#define PG8_SA(b, h) (((b) * 2 + (h)) * HTB)
#define PG8_SB(b, h) ((4 + (b) * 2 + (h)) * HTB)
#define PG8_STG(bufoff, base, o0, o1) do { \
        __builtin_amdgcn_global_load_lds((const unsigned*)((const char*)(base) + (o0)), (LAS unsigned*)(lds + (bufoff) + ldsw), 16, 0, 0); \
        __builtin_amdgcn_global_load_lds((const unsigned*)((const char*)(base) + (o1)), (LAS unsigned*)(lds + (bufoff) + ldsw + 8192), 16, 0, 0); } while (0)
#define PG8_STB(bufoff, base, h) PG8_STG(bufoff, (base) + (h) * (size_t)hstep, vB[0], vB[1])
#define PG8_STA(bufoff, base, h, g0, g1) do { if constexpr (GATHER) { PG8_STG(bufoff, base, g0, g1); } else { PG8_STG(bufoff, (base) + (h) * (size_t)hstep, vA[0], vA[1]); } } while (0)
#define PG8_LD8(p) __builtin_bit_cast(i32x8, __builtin_shufflevector(*(const LAS u32x4*)(p), *(const LAS u32x4*)((p) + 1024), 0, 1, 2, 3, 4, 5, 6, 7))
#define PG8_LDA(dst, b, h) do { _Pragma("unroll") for (int m = 0; m < 4; ++m) { if constexpr (F8) dst##8[m] = PG8_LD8(lds + PG8_SA(b, h) + aoff + m * 2048); else { _Pragma("unroll") for (int k = 0; k < 2; ++k) dst[m][k] = *(const LAS bf16x8*)(lds + PG8_SA(b, h) + aoff + m * 2048 + k * 1024); } } } while (0)
#define PG8_LDB(dst, b, h) do { _Pragma("unroll") for (int n = 0; n < 2; ++n) { if constexpr (F8) dst##8[n] = PG8_LD8(lds + PG8_SB(b, h) + boff + n * 2048); else { _Pragma("unroll") for (int k = 0; k < 2; ++k) dst[n][k] = *(const LAS bf16x8*)(lds + PG8_SB(b, h) + boff + n * 2048 + k * 1024); } } } while (0)
#define PG8_MMA(ai, bj, At, Bt) do { __builtin_amdgcn_s_setprio(1); _Pragma("unroll") for (int m = 0; m < 4; ++m) _Pragma("unroll") for (int n = 0; n < 2; ++n) { \
        if constexpr (F8) asm volatile("v_mfma_f32_16x16x128_f8f6f4 %0, %1, %2, %0" : "+v"(acc[ai][bj][m][n]) : "v"(Bt##8[n]), "v"(At##8[m])); \
        else { _Pragma("unroll") for (int k = 0; k < 2; ++k) acc[ai][bj][m][n] = __builtin_amdgcn_mfma_f32_16x16x32_bf16(Bt[n][k], At[m][k], acc[ai][bj][m][n], 0, 0, 0); } } __builtin_amdgcn_s_setprio(0); } while (0)
#define PG8_WAIT_V(n) asm volatile("s_waitcnt vmcnt(" #n ")" ::: "memory")
#define PG8_WAIT_L(n) asm volatile("s_waitcnt lgkmcnt(" #n ")" ::: "memory")
#define PG8_BAR __builtin_amdgcn_s_barrier()
#define PG8_SCHED __builtin_amdgcn_sched_barrier(0)
#define PG8_GOFF(g, u) do { _Pragma("unroll") for (int h = 0; h < 2; ++h) _Pragma("unroll") for (int i = 0; i < 2; ++i) { \
        if constexpr (GATHER) g[h][i] = (unsigned)(u).rows[h * HALF + Rr[i]] * (unsigned)(K * 2) + Cb[i]; else g[h][i] = 0u; } } while (0)
    Unit cur, nxt; int ui = 0;
    if (!S.next(0, cur)) return;
    f32x4 acc[2][2][4][2];
#pragma unroll
    for (int a = 0; a < 2; ++a)
#pragma unroll
        for (int b = 0; b < 2; ++b)
#pragma unroll
            for (int m = 0; m < 4; ++m)
#pragma unroll
                for (int n = 0; n < 2; ++n) acc[a][b][m][n] = (f32x4){0.f, 0.f, 0.f, 0.f};
    bf16x8 At[4][2], B0[2][2], B1[2][2]; i32x8 At8[4], B08[2], B18[2];
    unsigned gc[2][2], gn[2][2];
    PG8_GOFF(gc, cur);
    const char* cA = cur.A; const char* cB = cur.B;
#define PG8_AUX(u, slot) do { if constexpr (Epi::AUX >= 1) { if (wid < 4) __builtin_amdgcn_global_load_lds((const unsigned*)(S.aux0(u) + wid * 64 + lane), (LAS unsigned*)(auxl + (slot) * 512 + wid * 64), 4, 0, 0); } \
        if constexpr (Epi::AUX >= 2) { if (wid >= 4) __builtin_amdgcn_global_load_lds((const unsigned*)(S.aux1(u) + (wid - 4) * 64 + lane), (LAS unsigned*)(auxl + (slot) * 512 + 256 + (wid - 4) * 64), 4, 0, 0); } } while (0)
    PG8_AUX(cur, 0);
    PG8_STB(PG8_SB(0, 0), cB, 0); PG8_STB(PG8_SB(0, 1), cB, 1); PG8_STA(PG8_SA(0, 0), cA, 0, gc[0][0], gc[0][1]); PG8_STA(PG8_SA(0, 1), cA, 1, gc[1][0], gc[1][1]);
    if (wr == 1) PG8_BAR;
    PG8_WAIT_V(2); PG8_BAR;
    PG8_STB(PG8_SB(1, 0), cB + kstep, 0); PG8_STA(PG8_SA(1, 0), cA + kstep, 0, gc[0][0], gc[0][1]); PG8_STB(PG8_SB(1, 1), cB + kstep, 1);
    PG8_WAIT_V(6); PG8_BAR;
    for (;;) {
        const bool has_next = S.next(ui + 1, nxt);
        const char* nA = has_next ? nxt.A : cA; const char* nB = has_next ? nxt.B : cB;
        if constexpr (GATHER) { if (has_next && wid < 4) __builtin_amdgcn_global_load_lds((const unsigned*)(nxt.rows + wid * 64 + lane), (LAS unsigned*)(rowl + ((ui + 1) & 1) * 256 + wid * 64), 4, 0, 0); }
        if (has_next) PG8_AUX(nxt, (ui + 1) % 3);
#pragma nounroll
        for (int t = 0; t < nt; t += 2) {
            const bool last = (t == nt - 2);
            const char* a1 = cA + (size_t)(t + 1) * kstep;
            const char* a2 = last ? nA : cA + (size_t)(t + 2) * kstep; const char* b2 = last ? nB : cB + (size_t)(t + 2) * kstep;
            const char* a3 = a2 + kstep; const char* b3 = b2 + kstep;
            unsigned o00 = 0u, o01 = 0u, o10 = 0u, o11 = 0u;
            if constexpr (GATHER) {
                if (last && has_next) { const LAS int* rl = rowl + ((ui + 1) & 1) * 256;
#pragma unroll
                    for (int h = 0; h < 2; ++h)
#pragma unroll
                        for (int i = 0; i < 2; ++i) gn[h][i] = (unsigned)rl[h * HALF + Rr[i]] * (unsigned)(K * 2) + Cb[i]; }
                else {
#pragma unroll
                    for (int h = 0; h < 2; ++h)
#pragma unroll
                        for (int i = 0; i < 2; ++i) gn[h][i] = gc[h][i]; }
                o00 = gn[0][0]; o01 = gn[0][1]; o10 = gn[1][0]; o11 = gn[1][1]; }
            PG8_LDB(B0, 0, 0); PG8_LDB(B1, 0, 1); PG8_SCHED; PG8_LDA(At, 0, 0); PG8_STA(PG8_SA(1, 1), a1, 1, gc[1][0], gc[1][1]);
            PG8_WAIT_V(8); PG8_WAIT_L(0); PG8_BAR; PG8_MMA(0, 0, At, B0); PG8_MMA(0, 1, At, B1); PG8_BAR; PG8_SCHED;
            PG8_LDA(At, 0, 1); PG8_STB(PG8_SB(0, 0), b2, 0); PG8_STB(PG8_SB(0, 1), b2, 1); PG8_STA(PG8_SA(0, 0), a2, 0, o00, o01);
            PG8_WAIT_V(8); PG8_WAIT_L(0); PG8_BAR; PG8_MMA(1, 0, At, B0); PG8_MMA(1, 1, At, B1); PG8_BAR; PG8_SCHED;
            PG8_LDB(B0, 1, 0); PG8_LDB(B1, 1, 1); PG8_SCHED; PG8_LDA(At, 1, 0); PG8_STA(PG8_SA(0, 1), a2, 1, o10, o11);
            PG8_WAIT_V(8); PG8_WAIT_L(0); PG8_BAR; PG8_MMA(0, 0, At, B0); PG8_MMA(0, 1, At, B1); PG8_BAR; PG8_SCHED;
            PG8_LDA(At, 1, 1); PG8_STB(PG8_SB(1, 0), b3, 0); PG8_STB(PG8_SB(1, 1), b3, 1); PG8_STA(PG8_SA(1, 0), a3, 0, o00, o01);
            PG8_WAIT_V(8); PG8_WAIT_L(0); PG8_BAR; PG8_MMA(1, 0, At, B0); PG8_MMA(1, 1, At, B1); PG8_BAR; PG8_SCHED;
        }
        if constexpr (ALIGN_EPI) { if (wr == 0) PG8_BAR; }
        if constexpr (F8) asm volatile("s_nop 15\n\ts_nop 15" ::: "memory");
        E(acc, cur, wr, wc, fr, fq, (const LAS float*)(auxl + (ui % 3) * 512));
#if defined(EPI_REP)
        if (Epi::PROBE_ID == EPI_REP) E(acc, cur, wr, wc, fr, fq, (const LAS float*)(auxl + (ui % 3) * 512));
#endif
        if (!has_next) break;
#pragma unroll
        for (int a = 0; a < 2; ++a)
#pragma unroll
            for (int b = 0; b < 2; ++b)
#pragma unroll
                for (int m = 0; m < 4; ++m)
#pragma unroll
                    for (int n = 0; n < 2; ++n) acc[a][b][m][n] = (f32x4){0.f, 0.f, 0.f, 0.f};
        cur = nxt; cA = nA; cB = nB; ++ui;
#pragma unroll
        for (int h = 0; h < 2; ++h)
#pragma unroll
            for (int i = 0; i < 2; ++i) gc[h][i] = gn[h][i];
        if constexpr (ALIGN_EPI) { if (wr == 1) PG8_BAR; }
    }
    PG8_WAIT_V(0);
    if constexpr (!ALIGN_EPI) { if (wr == 0) PG8_BAR; }
    PG8_BAR;
#undef PG8_SA
#undef PG8_SB
#undef PG8_STG
#undef PG8_STB
#undef PG8_STA
#undef PG8_LDA
#undef PG8_LDB
#undef PG8_MMA
#undef PG8_LD8
#undef PG8_WAIT_V
#undef PG8_WAIT_L
#undef PG8_BAR
#undef PG8_SCHED
#undef PG8_GOFF
#undef PG8_AUX
}
}
using pg8::Unit;

struct EpiInProj {
    static constexpr bool PERM = true; static constexpr int PROBE_ID = 1, AUX = 0;
    bf16_t* qkv; const float* qg; const float* kg; const float* cosT; const float* sinT;
    __device__ __forceinline__ void operator()(const f32x4 (&acc)[2][2][4][2], const Unit& u, int wr, int wc, int fr, int fq, const LAS float* aux) const {
        const int row0 = u.pm * 256 + wr * 64 + fr;
        const int t = u.pn >> 1;
        bf16_t* base = qkv + (size_t)t * ((size_t)MTOK * 512);
        if (t < 2) {
            const float* g = (t == 0) ? qg : kg; const float sc = (t == 0) ? C2 : 1.0f;
            f32x4 glo[2], ghi[2];
#pragma unroll
            for (int n = 0; n < 2; ++n) { glo[n] = *(const f32x4*)(g + 8 * fq + 4 * n); ghi[n] = *(const f32x4*)(g + 32 + 8 * fq + 4 * n); }
            const int hh = (u.pn & 1) * 4 + wc;
#pragma unroll
            for (int ai = 0; ai < 2; ++ai)
#pragma unroll
                for (int m = 0; m < 4; ++m) {
                    const int row = row0 + ai * 128 + m * 16, pos = row & (SEQ - 1);
                    float ss = 0.f;
#pragma unroll
                    for (int bj = 0; bj < 2; ++bj)
#pragma unroll
                        for (int n = 0; n < 2; ++n) { const f32x4 v = acc[ai][bj][m][n]; ss += (v[0] * v[0] + v[1] * v[1]) + (v[2] * v[2] + v[3] * v[3]); }
                    ss += __shfl_xor(ss, 16); ss += __shfl_xor(ss, 32);
                    const float rs = 1.0f / sqrtf(ss * (1.0f / 64.0f) + 1e-6f);
                    u32x4 wlo, whi;
#pragma unroll
                    for (int n = 0; n < 2; ++n) {
                        const f32x4 cs = *(const f32x4*)(cosT + pos * 32 + 8 * fq + 4 * n), sn = *(const f32x4*)(sinT + pos * 32 + 8 * fq + 4 * n);
                        const f32x4 x1 = acc[ai][0][m][n] * rs * glo[n], x2 = acc[ai][1][m][n] * rs * ghi[n];
                        const f32x4 o1 = (x1 * cs - x2 * sn) * sc, o2 = (x2 * cs + x1 * sn) * sc;
                        wlo[2 * n] = cvt_pk_bf16(o1[0], o1[1]); wlo[2 * n + 1] = cvt_pk_bf16(o1[2], o1[3]);
                        whi[2 * n] = cvt_pk_bf16(o2[0], o2[1]); whi[2 * n + 1] = cvt_pk_bf16(o2[2], o2[3]);
                    }
                    if (t == 0) { bf16_t* p = base + (size_t)row * 512 + hh * 64 + 8 * fq; *(u32x4*)p = wlo; *(u32x4*)(p + 32) = whi; }
                    else {
                        bf16_t* p = base + ((((size_t)(row >> 6) * 8 + hh) * 8 + fq) * 64 + (row & 63)) * 8; *(u32x4*)p = wlo; *(u32x4*)(p + 4 * 512) = whi; }
                }
        } else {
            const int col0 = (u.pn & 1) * 256 + wc * 32 + 8 * fq;
#pragma unroll
            for (int ai = 0; ai < 2; ++ai)
#pragma unroll
                for (int m = 0; m < 4; ++m) { const int row = row0 + ai * 128 + m * 16;
                    bf16_t* rowp = (t == 2) ? base + (((size_t)(row >> 6) * 4 + (col0 >> 7)) * 64 + (row & 63)) * 128 + (col0 & 127) : base + (size_t)row * 512 + col0;
#pragma unroll
                    for (int bj = 0; bj < 2; ++bj) { const f32x4 v0 = acc[ai][bj][m][0], v1 = acc[ai][bj][m][1]; u32x4 w;
                        w.x = cvt_pk_bf16(v0[0], v0[1]); w.y = cvt_pk_bf16(v0[2], v0[3]); w.z = cvt_pk_bf16(v1[0], v1[1]); w.w = cvt_pk_bf16(v1[2], v1[3]);
                        *(u32x4*)(rowp + bj * ((t == 2) ? 64 * 128 : 128)) = w; } }
        }
    }
};
struct EpiOutProj {
    static constexpr bool PERM = true; static constexpr int PROBE_ID = 2, AUX = 0;
    const float* x; bf16_t* x1b; const float* modv; float* ssq;
    __device__ __forceinline__ void operator()(const f32x4 (&acc)[2][2][4][2], const Unit& u, int wr, int wc, int fr, int fq, const LAS float* aux) const {
        const int row0 = u.pm * 256 + wr * 64 + fr, b = u.pm >> 5, col0 = u.pn * 256 + wc * 32 + 8 * fq;
        const float* g1 = modv + (size_t)b * 6144 + 2048;
        f32x4 gv[2][2];
#pragma unroll
        for (int bj = 0; bj < 2; ++bj)
#pragma unroll
            for (int n = 0; n < 2; ++n) gv[bj][n] = *(const f32x4*)(g1 + col0 + bj * 128 + n * 4);
#pragma unroll
        for (int ai = 0; ai < 2; ++ai)
#pragma unroll
            for (int m = 0; m < 4; ++m) { const int row = row0 + ai * 128 + m * 16; const size_t ro = (size_t)row * DM + col0; float sq = 0.f;
#pragma unroll
                for (int bj = 0; bj < 2; ++bj) { f32x4 o[2];
#pragma unroll
                    for (int n = 0; n < 2; ++n) { const f32x4 xv = __builtin_nontemporal_load((const f32x4*)(x + ro + bj * 128 + n * 4)); o[n] = xv + gv[bj][n] * acc[ai][bj][m][n];
                        sq += (o[n][0] * o[n][0] + o[n][1] * o[n][1]) + (o[n][2] * o[n][2] + o[n][3] * o[n][3]); }
                    u32x4 w; w.x = cvt_pk_bf16(o[0][0], o[0][1]); w.y = cvt_pk_bf16(o[0][2], o[0][3]); w.z = cvt_pk_bf16(o[1][0], o[1][1]); w.w = cvt_pk_bf16(o[1][2], o[1][3]);
                    *(u32x4*)(x1b + ro + bj * 128) = w; }
                sq += __shfl_xor(sq, 16); sq += __shfl_xor(sq, 32);
                if (fq == 0) ssq[(size_t)row * 16 + u.pn * 4 + wc] = sq; }
    }
};
__device__ __forceinline__ u32x2 pack_fp8x8(const float (&o)[8]) { int w0 = 0, w1 = 0;
    w0 = __builtin_amdgcn_cvt_pk_fp8_f32(o[0], o[1], w0, false); w0 = __builtin_amdgcn_cvt_pk_fp8_f32(o[2], o[3], w0, true);
    w1 = __builtin_amdgcn_cvt_pk_fp8_f32(o[4], o[5], w1, false); w1 = __builtin_amdgcn_cvt_pk_fp8_f32(o[6], o[7], w1, true); u32x2 r; r.x = (unsigned)w0; r.y = (unsigned)w1; return r; }
__device__ __forceinline__ u32x4 pair16(u32x2 p, u32x2 q) {
    const auto rx = __builtin_amdgcn_permlane16_swap(p.x, q.x, false, false); const auto ry = __builtin_amdgcn_permlane16_swap(p.y, q.y, false, false);
    return (u32x4){rx[0], ry[0], rx[1], ry[1]}; }
constexpr float WSCALE = 64.0f, WINV = 1.0f / 64.0f;
struct EpiMoe1 {
    static constexpr bool PERM = true; static constexpr int PROBE_ID = 3, AUX = 0;
    unsigned char* act; const float* b1;
    __device__ __forceinline__ void operator()(const f32x4 (&acc)[2][2][4][2], const Unit& u, int wr, int wc, int fr, int fq, const LAS float* aux) const {
        const int row0 = u.pm * 256 + wr * 64 + fr, col0 = u.pn * 128 + wc * 32 + 8 * fq;
        f32x4 bg[2], bl[2];
#pragma unroll
        for (int n = 0; n < 2; ++n) { bg[n] = *(const f32x4*)(b1 + (size_t)u.e * 2048 + col0 + 4 * n); bl[n] = *(const f32x4*)(b1 + (size_t)u.e * 2048 + 1024 + col0 + 4 * n) + 1.0f; }
#pragma unroll
        for (int ai = 0; ai < 2; ++ai)
#pragma unroll
            for (int mp = 0; mp < 2; ++mp) { u32x2 pk[2];
#pragma unroll
              for (int mi = 0; mi < 2; ++mi) { const int m = 2 * mp + mi;
                float o[8];
#pragma unroll
                for (int n = 0; n < 2; ++n)
#pragma unroll
                    for (int p = 0; p < 2; ++p) {
                        const f32x2 a0 = {acc[ai][0][m][n][2 * p], acc[ai][0][m][n][2 * p + 1]}, a1 = {acc[ai][1][m][n][2 * p], acc[ai][1][m][n][2 * p + 1]};
                        const f32x2 bgp = {bg[n][2 * p], bg[n][2 * p + 1]}, blp = {bl[n][2 * p], bl[n][2 * p + 1]};
                        f32x2 g = a0 * WINV + bgp; g.x = fminf(g.x, 7.0f); g.y = fminf(g.y, 7.0f);
                        const f32x2 z = g * (-2.4554669596f);
                        f32x2 e; e.x = __builtin_amdgcn_exp2f(z.x); e.y = __builtin_amdgcn_exp2f(z.y);
                        const f32x2 d = e + 1.0f;
                        f32x2 r; r.x = __builtin_amdgcn_rcpf(d.x); r.y = __builtin_amdgcn_rcpf(d.y);
                        f32x2 l = a1 * WINV + blp; l.x = __builtin_amdgcn_fmed3f(l.x, -6.0f, 8.0f); l.y = __builtin_amdgcn_fmed3f(l.y, -6.0f, 8.0f);
                        const f32x2 v = (g * r) * l;
                        o[4 * n + 2 * p] = v.x; o[4 * n + 2 * p + 1] = v.y;
                    }
                pk[mi] = pack_fp8x8(o); }
              *(u32x4*)(act + (size_t)(row0 + ai * 128 + (2 * mp + (fq & 1)) * 16) * 1024 + col0 - 8 * (fq & 1)) = pair16(pk[0], pk[1]);
            }
    }
};
constexpr float YSCALE = 16.0f, YINV = 1.0f / 16.0f;
struct EpiMoe2 {
    static constexpr bool PERM = true; static constexpr int PROBE_ID = 4, AUX = 2;
    unsigned char* y; const float* b2; const float* rowg;
    __device__ __forceinline__ void operator()(const f32x4 (&acc)[2][2][4][2], const Unit& u, int wr, int wc, int fr, int fq, const LAS float* aux) const {
        const int row0 = u.pm * 256 + wr * 64 + fr, col0 = u.pn * 256 + wc * 32 + 8 * fq;
        f32x4 bv[2][2];
#pragma unroll
        for (int bj = 0; bj < 2; ++bj)
#pragma unroll
            for (int n = 0; n < 2; ++n) bv[bj][n] = *(const LAS f32x4*)(aux + bj * 128 + wc * 32 + 8 * fq + 4 * n);
#pragma unroll
        for (int ai = 0; ai < 2; ++ai)
#pragma unroll
            for (int mp = 0; mp < 2; ++mp) { u32x2 pk[2][2];
#pragma unroll
                for (int mi = 0; mi < 2; ++mi) { const int m = 2 * mp + mi; const float gt = aux[256 + ai * 128 + wr * 64 + m * 16 + fr] * YSCALE, gw = gt * WINV;
#pragma unroll
                    for (int bj = 0; bj < 2; ++bj) { const f32x4 v0 = acc[ai][bj][m][0] * gw + bv[bj][0] * gt, v1 = acc[ai][bj][m][1] * gw + bv[bj][1] * gt;
                        const float o[8] = {v0[0], v0[1], v0[2], v0[3], v1[0], v1[1], v1[2], v1[3]}; pk[mi][bj] = pack_fp8x8(o); } }
                unsigned char* rowp = y + (size_t)(row0 + ai * 128 + (2 * mp + (fq & 1)) * 16) * 1024 + col0 - 8 * (fq & 1);
#pragma unroll
                for (int bj = 0; bj < 2; ++bj) *(u32x4*)(rowp + bj * 128) = pair16(pk[0][bj], pk[1][bj]); }
    }
};
struct MoeOrder {
    int c, lg, per, ntiles; const LAS int* tile_e; const int* rowtok; const char* Ab; size_t a_tstep; const char* Bt; size_t estride, b_tstep; const float* bias; int bias_e, bias_pn; const float* rowg;
    __device__ bool next(int i, Unit& u) const {
        const int w = c >> 3, mt = (c & 7) + 8 * (per * i + (w >> lg)), pn = w & ((1 << lg) - 1); if (mt >= ntiles) return false;
        const int e = __builtin_amdgcn_readfirstlane(tile_e[mt]);
        u.pm = mt; u.pn = pn; u.e = e; u.A = Ab + (size_t)mt * a_tstep; u.B = Bt + (size_t)e * estride + (size_t)pn * b_tstep; u.rows = rowtok + 256 * mt; return true;
    }
    __device__ const float* aux0(const Unit& u) const { return bias + (size_t)u.e * bias_e + u.pn * bias_pn; }
    __device__ const float* aux1(const Unit& u) const { return rowg ? rowg + 256 * u.pm : bias + (size_t)u.e * bias_e + u.pn * bias_pn + 1024; }
};

#define XB_TMO      128
#define XB_XCNT(j)  (256  + 64 * (j))
#define XB_XSUB(j)  (1280 + 64 * (j))
#define XB_XGEN(j)  (2304 + 64 * (j))
#define XB_TOP      3328
#define XB_TOPGEN   3392
#define XCD_BAR_WORDS 3456
#define XB_SPIN_CAP (1u << 21)
__device__ __forceinline__ unsigned xb_ld(unsigned* p)              { return __hip_atomic_load(p, __ATOMIC_RELAXED, __HIP_MEMORY_SCOPE_AGENT); }
__device__ __forceinline__ unsigned xb_add(unsigned* p, unsigned v) { return __hip_atomic_fetch_add(p, v, __ATOMIC_RELAXED, __HIP_MEMORY_SCOPE_AGENT); }
__device__ __forceinline__ unsigned xb_xcc_id() { return (unsigned)__builtin_amdgcn_s_getreg((3 << 11) | 20) & 0xFu; }
#define XB_SPIN(cond, bar) do { unsigned _sp = 0; while (cond) { __builtin_amdgcn_s_sleep(1); \
    if ((++_sp & 255u) == 0u) { if (xb_ld(&(bar)[XB_TMO])) break; if (_sp > XB_SPIN_CAP) { atomicAdd(&(bar)[XB_TMO], 1u); break; } } } } while (0)
struct XcdBarrier { unsigned* bar; unsigned x; volatile LAS unsigned* st; };
__device__ __forceinline__ XcdBarrier xcd_barrier_post(unsigned* bar, volatile LAS unsigned* st) {
    XcdBarrier b; b.bar = bar; b.x = xb_xcc_id(); b.st = st;
    if (threadIdx.x == 0) (void)xb_add(&bar[XB_XCNT(b.x)], 1u);
    return b;
}
__device__ __forceinline__ void xcd_barrier_complete(unsigned* bar, unsigned x, unsigned& nloc, unsigned& nx) {
    const unsigned G = gridDim.x * gridDim.y * gridDim.z;
    unsigned sum, cnt, mine, sp = 0u;
    for (;;) {
        sum = 0u; cnt = 0u; mine = 0u;
#pragma unroll
        for (unsigned j = 0; j < 16; ++j) { const unsigned c = xb_ld(&bar[XB_XCNT(j)]); sum += c; cnt += (c > 0u) ? 1u : 0u; mine = (j == x) ? c : mine; }
        if (sum == G) break;
        __builtin_amdgcn_s_sleep(1);
        if ((++sp & 255u) == 0u) { if (xb_ld(&bar[XB_TMO])) break; if (sp > XB_SPIN_CAP) { atomicAdd(&bar[XB_TMO], 1u); break; } }
    }
    nloc = mine > 0u ? mine : 1u; nx = cnt > 0u ? cnt : 1u;
}
__device__ __forceinline__ void xcd_barrier(const XcdBarrier& b) {
    asm volatile("s_waitcnt vmcnt(0)" ::: "memory");
    __syncthreads();
    if (threadIdx.x == 0) {
        unsigned* bar = b.bar;
        __builtin_amdgcn_s_waitcnt(0);
        unsigned nloc = b.st[0], nx = b.st[1];
        if (nloc == 0u) { xcd_barrier_complete(bar, b.x, nloc, nx); b.st[0] = nloc; b.st[1] = nx; }
        const unsigned old = xb_add(&bar[XB_XSUB(b.x)], 1u);
        const unsigned gen = old / nloc;
        if (old + 1u == (gen + 1u) * nloc) {
            __builtin_amdgcn_fence(__ATOMIC_RELEASE, "agent");
            asm volatile("s_waitcnt vmcnt(0)" ::: "memory");
            const unsigned og = xb_add(&bar[XB_TOP], 1u);
            const unsigned tg = og / nx;
            if (og + 1u == (tg + 1u) * nx) xb_add(&bar[XB_TOPGEN], 1u);
            else XB_SPIN(xb_ld(&bar[XB_TOPGEN]) == tg, bar);
            __builtin_amdgcn_fence(__ATOMIC_ACQUIRE, "agent");
            xb_add(&bar[XB_XGEN(b.x)], 1u);
            asm volatile("s_waitcnt vmcnt(0)" ::: "memory");
        } else {
            XB_SPIN(xb_ld(&bar[XB_XGEN(b.x)]) == gen, bar);
            __builtin_amdgcn_fence(__ATOMIC_ACQUIRE, "agent");
            asm volatile("s_waitcnt vmcnt(0)" ::: "memory");
        }
    }
    __syncthreads();
}

struct Args { const float* in[28]; float* out; unsigned char* ws; int ph_lo, ph_hi; };
enum { I_X = 0, I_C, I_WADA, I_BADA, I_N1G, I_WIN, I_QG, I_KG, I_LQ1, I_LK1, I_LQ2, I_LK2, I_SUBG, I_CONVW, I_CONVB, I_WRGA, I_BRGA, I_WRGX, I_BRGX, I_LRUL, I_WOUT, I_N2G, I_WR, I_BR, I_W1, I_B1, I_W2, I_B2 };

__device__ __forceinline__ int map_row(int mode, int s) {
    if (mode == 1) { const int pn = s >> 8; if (pn < 4) { const int wc = (s & 255) >> 6, dim = s & 63; return (pn << 8) + ((dim >> 5) << 7) + (wc << 5) + (dim & 31); } return s; }
    if (mode == 2) { const int lin = s >> 10, s2 = s & 1023; return ((s2 >> 7) << 8) + (lin << 7) + (s2 & 127); }
    return s;
}
__device__ __forceinline__ void transpose_item(const float* W, int K, int N, bf16_t* WT, int mode, LAS float* scr, int item, int lane) {
    const int nblk = N / 32, kb = item / nblk, nb = item % nblk, k0 = 64 * kb, n0 = 32 * nb;
    { float wv[32];
#pragma unroll
      for (int i = 0; i < 32; ++i) wv[i] = __builtin_nontemporal_load(W + (size_t)(k0 + 2 * i + (lane >> 5)) * N + n0 + (lane & 31));
#pragma unroll
      for (int i = 0; i < 32; ++i) scr[(2 * i + (lane >> 5)) * 33 + (lane & 31)] = wv[i]; }
    LDS_WAIT(); asm volatile("" ::: "memory");
    const int c = lane & 7;
#pragma unroll
    for (int j = 0; j < 4; ++j) { const int n = (lane >> 3) + 8 * j; const LAS float* s = scr + (8 * c) * 33 + n;
        u32x4 o; o.x = cvt_pk_bf16(s[0 * 33], s[1 * 33]); o.y = cvt_pk_bf16(s[2 * 33], s[3 * 33]); o.z = cvt_pk_bf16(s[4 * 33], s[5 * 33]); o.w = cvt_pk_bf16(s[6 * 33], s[7 * 33]);
        *(u32x4*)(WT + (size_t)map_row(mode, n0 + n) * K + k0 + 8 * c) = o; }
    LDS_WAIT(); asm volatile("" ::: "memory");
}
__device__ __forceinline__ void transpose_item_f8(const float* W, int K, int N, unsigned char* WT, int mode, LAS float* scr, int item, int lane) {
    const int nblk = N / 32, kb = item / nblk, nb = item % nblk, k0 = 64 * kb, n0 = 32 * nb;
    { float wv[32];
#pragma unroll
      for (int i = 0; i < 32; ++i) wv[i] = __builtin_nontemporal_load(W + (size_t)(k0 + 2 * i + (lane >> 5)) * N + n0 + (lane & 31));
#pragma unroll
      for (int i = 0; i < 32; ++i) scr[(2 * i + (lane >> 5)) * 33 + (lane & 31)] = wv[i]; }
    LDS_WAIT(); asm volatile("" ::: "memory");
    const int c = lane & 7;
#pragma unroll
    for (int j = 0; j < 4; ++j) { const int n = (lane >> 3) + 8 * j; const LAS float* sp = scr + (8 * c) * 33 + n;
        const float o[8] = {sp[0 * 33] * WSCALE, sp[1 * 33] * WSCALE, sp[2 * 33] * WSCALE, sp[3 * 33] * WSCALE, sp[4 * 33] * WSCALE, sp[5 * 33] * WSCALE, sp[6 * 33] * WSCALE, sp[7 * 33] * WSCALE};
        *(u32x2*)(WT + (size_t)map_row(mode, n0 + n) * K + k0 + 8 * c) = pack_fp8x8(o); }
    LDS_WAIT(); asm volatile("" ::: "memory");
}
__device__ __forceinline__ double sin_poly(double x) { const double x2 = x * x; double p = -1.0 / 51090942171709440000.0;
    p = p * x2 + 1.0 / 121645100408832000.0; p = p * x2 - 1.0 / 355687428096000.0; p = p * x2 + 1.0 / 1307674368000.0; p = p * x2 - 1.0 / 6227020800.0; p = p * x2 + 1.0 / 39916800.0;
    p = p * x2 - 1.0 / 362880.0; p = p * x2 + 1.0 / 5040.0; p = p * x2 - 1.0 / 120.0; p = p * x2 + 1.0 / 6.0; p = p * x2 - 1.0; return -p * x; }
__device__ __forceinline__ double cos_poly(double x) { const double x2 = x * x; double p = -1.0 / 1124000727777607680000.0;
    p = p * x2 + 1.0 / 2432902008176640000.0; p = p * x2 - 1.0 / 6402373705728000.0; p = p * x2 + 1.0 / 20922789888000.0; p = p * x2 - 1.0 / 87178291200.0; p = p * x2 + 1.0 / 479001600.0;
    p = p * x2 - 1.0 / 3628800.0; p = p * x2 + 1.0 / 40320.0; p = p * x2 - 1.0 / 720.0; p = p * x2 + 1.0 / 24.0; p = p * x2 - 0.5; p = p * x2 + 1.0; return p; }

__device__ __forceinline__ void phase_mod(const Args& a, LAS unsigned char* lds, int bid, int G, int tid, int lane, int wave) {
    unsigned char* ws = a.ws;
    LAS float* sl = (LAS float*)(lds + 65536);
    const int gw = bid * NWAVES + wave;
    if (bid * NWAVES < 768) {
        const float* c = a.in[I_C];
        for (int i = tid; i < NB * DM; i += 512) { const float v = c[i]; sl[i] = v / (1.0f + __expf(-v)); }
        __syncthreads();
        if (gw < 768) {
            const int cg = gw >> 3, ks = gw & 7;
            const int n = cg * 64 + lane; const float* w = a.in[I_WADA] + (size_t)(ks * 128) * 6144 + n;
            float acc[8];
#pragma unroll
            for (int b = 0; b < 8; ++b) acc[b] = 0.f;
            for (int k0 = 0; k0 < 128; k0 += 16) {
                float wv[16];
#pragma unroll
                for (int j = 0; j < 16; ++j) wv[j] = w[(size_t)(k0 + j) * 6144];
#pragma unroll
                for (int j = 0; j < 16; ++j)
#pragma unroll
                    for (int b = 0; b < 8; ++b) acc[b] += sl[b * DM + ks * 128 + k0 + j] * wv[j];
            }
            float* mp = (float*)(ws + WS_MODP);
#pragma unroll
            for (int b = 0; b < 8; ++b) mp[(size_t)(ks * 8 + b) * 6144 + n] = acc[b];
        }
        __syncthreads();
    }
}
__device__ __forceinline__ void phase_misc(const Args& a, LAS unsigned char* lds, int bid, int G, int tid, int lane, int wave) {
    unsigned char* ws = a.ws;
    { float* cosT = (float*)(ws + WS_ROPE); float* sinT = cosT + SEQ * 32;
      for (int idx = bid * 512 + tid; idx < SEQ * 32; idx += G * 512) { const int pos = idx >> 5, i = idx & 31;
          const float inv = exp2f(-(float)i * (13.287712379549449f / 32.0f)); const float ang = (float)pos * inv;
          double r = (double)ang * 0.15915494309189535; r -= rint(r); const double xr = r * 6.283185307179586;
          cosT[idx] = (float)cos_poly(xr); sinT[idx] = (float)sin_poly(xr); } }
    if (bid == 96 && wave == 0) {
        const float s1 = wave_sum(a.in[I_LQ1][lane] * a.in[I_LK1][lane]), s2 = wave_sum(a.in[I_LQ2][lane] * a.in[I_LK2][lane]);
        const float gq = wave_max(fabsf(a.in[I_QG][lane])), gk = wave_max(fabsf(a.in[I_KG][lane]));
        float* sc = (float*)(ws + WS_SCAL);
        if (lane == 0) { sc[0] = expf(s1) - expf(s2) + 0.2f; sc[1] = 8.0f * gq * gk * 1.4426950408889634f * 1.01f + 0.05f; }
    }
    if (bid == 97) { float* cd = (float*)(ws + WS_SCAL + 4096); const float xl = -a.in[I_LRUL][tid]; cd[tid] = 8.0f * (fmaxf(xl, 0.f) + log1pf(expf(-fabsf(xl)))); }
    { bf16_t* wg = (bf16_t*)(ws + WS_WGT);
      for (int idx = bid * 512 + tid; idx < 8 * 2 * 64 * 64; idx += G * 512) { const int cc = idx & 63, d = (idx >> 6) & 63, g = (idx >> 12) & 1, n = idx >> 13;
          const float v = (g == 0 ? a.in[I_WRGA] : a.in[I_WRGX])[(size_t)(n * 64 + cc) * 64 + d]; wg[idx] = (bf16_t)(cvt_pk_bf16(v, 0.f) & 0xffffu); } }
    { bf16_t* wf = (bf16_t*)(ws + WS_WRF);
      for (int idx = bid * 512 + tid; idx < 64 * 64 * 8; idx += G * 512) { const int sI = idx & 7, ln = (idx >> 3) & 63, ks = idx >> 9; const float w = a.in[I_WR][(size_t)(16 * ks + 8 * (ln >> 5) + sI) * 32 + (ln & 31)];
          const unsigned hb = cvt_pk_bf16(w, 0.f) & 0xffffu; const float lo = w - __uint_as_float(hb << 16); wf[idx] = (bf16_t)hb; wf[32768 + idx] = (bf16_t)(cvt_pk_bf16(lo, 0.f) & 0xffffu); } }
    LAS float* scr = (LAS float*)(lds + 16384 + wave * 8704);
    const int gw = bid * NWAVES + wave, NGW = G * NWAVES;
    constexpr int I_IN = 16 * (INW / 32), I_OUT = 16 * 32;
    for (int it = gw; it < I_IN + I_OUT; it += NGW) {
        if (it < I_IN) transpose_item(a.in[I_WIN], DM, INW, (bf16_t*)(ws + WS_WIN), 1, scr, it, lane);
        else transpose_item(a.in[I_WOUT], DM, DM, (bf16_t*)(ws + WS_WOUT), 0, scr, it - I_IN, lane);
    }
}
__device__ __forceinline__ void convert_expert_weights(const Args& a, LAS unsigned char* lds, int bid, int G, int lane, int wave) {
    unsigned char* ws = a.ws;
    LAS float* scr = (LAS float*)(lds + 16384 + wave * 8704);
    const int gw = bid * NWAVES + wave, NGW = G * NWAVES;
    constexpr int I_M1E = 16 * 64, I_M2E = 16 * 32;
    for (int it = gw; it < NEXP * (I_M1E + I_M2E); it += NGW) {
        if (it < NEXP * I_M1E) { const int e = it / I_M1E; transpose_item_f8(a.in[I_W1] + (size_t)e * DM * 2048, DM, 2048, (unsigned char*)(ws + WS_W1) + (size_t)e * 2048 * DM, 2, scr, it % I_M1E, lane); }
        else { const int r = it - NEXP * I_M1E, e = r / I_M2E; transpose_item_f8(a.in[I_W2] + (size_t)e * DFF * DM, DFF, DM, (unsigned char*)(ws + WS_W2) + (size_t)e * DM * DFF, 0, scr, r % I_M2E, lane); }
    }
}

__device__ __forceinline__ void phase_hn(const Args& a, LAS unsigned char* lds, int bid, int G, int tid, int lane, int wave) {
    unsigned char* ws = a.ws;
    LAS float* A1 = (LAS float*)lds; LAS float* SH = A1 + DM;
    const float* mp = (const float*)(ws + WS_MODP); const float* bada = a.in[I_BADA]; float* modv = (float*)(ws + WS_MODV);
    for (int tile = bid; tile < MTOK / 256; tile += G) {
        const int b = tile >> 5;
        for (int col = tid; col < DM; col += 512) {
            float sh = bada[col], sc = bada[DM + col];
#pragma unroll
            for (int ks = 0; ks < 8; ++ks) { sh += mp[(size_t)(ks * 8 + b) * 6144 + col]; sc += mp[(size_t)(ks * 8 + b) * 6144 + DM + col]; }
            A1[col] = a.in[I_N1G][col] * (1.0f + sc); SH[col] = sh;
        }
        if ((tile & 31) == 0) for (int n = tid; n < 6144; n += 512) { float v = bada[n];
#pragma unroll
            for (int ks = 0; ks < 8; ++ks) v += mp[(size_t)(ks * 8 + b) * 6144 + n];
            modv[(size_t)b * 6144 + n] = v; }
        __syncthreads();
        f32x4 av[4], sv[4];
#pragma unroll
        for (int j = 0; j < 4; ++j) { av[j] = *(const LAS f32x4*)(A1 + 4 * lane + 256 * j); sv[j] = *(const LAS f32x4*)(SH + 4 * lane + 256 * j); }
        for (int r = 0; r < 32; r += 2) {
            const size_t row = (size_t)tile * 256 + wave * 32 + r;
            const f32x4* xr = (const f32x4*)(a.in[I_X] + row * DM) + lane;
            f32x4 v[2][4]; float sq[2] = {0.f, 0.f};
#pragma unroll
            for (int q = 0; q < 2; ++q)
#pragma unroll
                for (int j = 0; j < 4; ++j) v[q][j] = __builtin_nontemporal_load(xr + q * (DM / 4) + 64 * j);
#pragma unroll
            for (int q = 0; q < 2; ++q)
#pragma unroll
                for (int j = 0; j < 4; ++j) sq[q] += (v[q][j][0] * v[q][j][0] + v[q][j][1] * v[q][j][1]) + (v[q][j][2] * v[q][j][2] + v[q][j][3] * v[q][j][3]);
#pragma unroll
            for (int q = 0; q < 2; ++q) {
                const float rstd = 1.0f / sqrtf(wave_sum(sq[q]) * (1.0f / DM) + 1e-6f);
                u32x2* o8 = (u32x2*)((bf16_t*)(ws + WS_XN) + (row + q) * DM) + lane;
#pragma unroll
                for (int j = 0; j < 4; ++j) { const f32x4 y = v[q][j] * rstd * av[j] + sv[j]; u32x2 w; w.x = cvt_pk_bf16(y[0], y[1]); w.y = cvt_pk_bf16(y[2], y[3]); o8[64 * j] = w; }
            }
        }
        __syncthreads();
    }
}

constexpr int LRU_WAVE_LDS = 12544;
template <bool FINAL>
__device__ __forceinline__ void lru_wave(const Args& a, unsigned char* ws, LAS unsigned char* wl, int b, int n, int c0, int nch, int lane) {
    LAS bf16_t* XCB = (LAS bf16_t*)wl;
    LAS float* AA = (LAS float*)(wl + 2304);
    LAS float* UU = AA + 1024;
    LAS float* CW = UU + 1024;
    const int fr = lane & 15, fq = lane >> 4, cg = lane & 7, rp = lane >> 3, chn = n * 64 + lane;
#pragma unroll
    for (int j = 0; j < 4; ++j) CW[j * 64 + lane] = a.in[I_CONVW][j * 512 + chn];
    CW[256 + lane] = a.in[I_CONVB][chn]; CW[320 + lane] = a.in[I_BRGA][chn]; CW[384 + lane] = a.in[I_BRGX][chn]; CW[448 + lane] = ((const float*)(ws + WS_SCAL + 4096))[chn] * 1.4426950408889634f;
    bf16x8 wa[4][2], wx[4][2];
    { const bf16_t* wg = (const bf16_t*)(ws + WS_WGT) + (size_t)n * 2 * 4096;
#pragma unroll
      for (int cb = 0; cb < 4; ++cb)
#pragma unroll
          for (int ks = 0; ks < 2; ++ks) { wa[cb][ks] = *(const bf16x8*)(wg + (size_t)(16 * cb + fr) * 64 + 32 * ks + 8 * fq); wx[cb][ks] = *(const bf16x8*)(wg + 4096 + (size_t)(16 * cb + fr) * 64 + 32 * ks + 8 * fq); } }
    const bf16_t* XR = (const bf16_t*)(ws + WS_Q) + (size_t)3 * MTOK * 512 + (size_t)b * SEQ * 512 + n * 64 + cg * 8;
    const bf16_t* GR = (const bf16_t*)(ws + WS_Q) + (size_t)4 * MTOK * 512 + (size_t)b * SEQ * 512 + n * 64 + cg * 8;
    bf16_t* MIXp = (bf16_t*)(ws + WS_MIX) + (size_t)b * SEQ * DM + 512 + n * 64 + cg * 8;
    bf16_t* HLp = (bf16_t*)(ws + WS_HL) + (size_t)b * SEQ * 512 + n * 64 + cg * 8; bf16_t* PPp = (bf16_t*)(ws + WS_PP) + (size_t)b * SEQ * 512 + n * 64 + cg * 8; (void)HLp; (void)PPp;
    f32x2* carry = (f32x2*)(ws + WS_CARRY) + (size_t)b * 64 * 512 + n * 64 + lane;
    float hrun = 0.f;
    if constexpr (FINAL) {
#pragma unroll 8
        for (int cc = 0; cc < c0; ++cc) { const f32x2 v = carry[(size_t)cc * 512]; hrun = v.x * hrun + v.y; }
    }
    asm volatile("s_waitcnt lgkmcnt(0)" ::: "memory");
    u32x4 xn[5], gn[2];
    { const int s0 = c0 * 128;
#pragma unroll
      for (int j = 0; j < 5; ++j) { const int pos = s0 + 2 * rp - 3 + j; xn[j] = (u32x4){0u, 0u, 0u, 0u}; if (pos >= 0) xn[j] = *(const u32x4*)(XR + (size_t)pos * 512); }
      if constexpr (FINAL) { gn[0] = *(const u32x4*)(GR + (size_t)(s0 + 2 * rp) * 512); gn[1] = *(const u32x4*)(GR + (size_t)(s0 + 2 * rp + 1) * 512); } }
    for (int ci = 0; ci < nch; ++ci) {
        const int c = c0 + ci; float Ap = 1.f, Hp = 0.f;
        for (int st = 0; st < 8; ++st) {
            const int s0 = c * 128 + st * 16;
            u32x4 xv[5], gv[2];
#pragma unroll
            for (int j = 0; j < 5; ++j) xv[j] = xn[j];
            if constexpr (FINAL) { gv[0] = gn[0]; gv[1] = gn[1]; }
            { const int s1 = (st == 7 && ci == nch - 1) ? s0 : s0 + 16;
#pragma unroll
              for (int j = 0; j < 5; ++j) { const int pos = s1 + 2 * rp - 3 + j; xn[j] = (u32x4){0u, 0u, 0u, 0u}; if (pos >= 0) xn[j] = *(const u32x4*)(XR + (size_t)pos * 512); }
              if constexpr (FINAL) { gn[0] = *(const u32x4*)(GR + (size_t)(s1 + 2 * rp) * 512); gn[1] = *(const u32x4*)(GR + (size_t)(s1 + 2 * rp + 1) * 512); } }
            { float cw[4][8], cbv[8];
#pragma unroll
              for (int j = 0; j < 4; ++j) { const f32x4 w0 = *(const LAS f32x4*)(CW + j * 64 + cg * 8), w1 = *(const LAS f32x4*)(CW + j * 64 + cg * 8 + 4);
#pragma unroll
                  for (int i = 0; i < 4; ++i) { cw[j][i] = w0[i]; cw[j][4 + i] = w1[i]; } }
              { const f32x4 b0 = *(const LAS f32x4*)(CW + 256 + cg * 8), b1 = *(const LAS f32x4*)(CW + 256 + cg * 8 + 4);
#pragma unroll
                for (int i = 0; i < 4; ++i) { cbv[i] = b0[i]; cbv[4 + i] = b1[i]; } }
#pragma unroll
              for (int rr = 0; rr < 2; ++rr) { float xc[8];
#pragma unroll
                  for (int i = 0; i < 8; ++i) xc[i] = cbv[i];
#pragma unroll
                  for (int j = 0; j < 4; ++j)
#pragma unroll
                      for (int q = 0; q < 4; ++q) { xc[2 * q] += cw[j][2 * q] * bflo(xv[rr + j][q]); xc[2 * q + 1] += cw[j][2 * q + 1] * bfhi(xv[rr + j][q]); }
                  u32x4 w; w.x = cvtpk(xc[0], xc[1]); w.y = cvtpk(xc[2], xc[3]); w.z = cvtpk(xc[4], xc[5]); w.w = cvtpk(xc[6], xc[7]);
                  *(LAS u32x4*)(XCB + (2 * rp + rr) * 72 + cg * 8) = w; } }
            asm volatile("s_waitcnt lgkmcnt(0)" ::: "memory");
            { bf16x8 xf[2];
#pragma unroll
              for (int ks = 0; ks < 2; ++ks) xf[ks] = *(const LAS bf16x8*)(XCB + fr * 72 + 32 * ks + 8 * fq);
#pragma unroll
              for (int cb = 0; cb < 4; ++cb) {
                  f32x4 ga = (f32x4){0.f, 0.f, 0.f, 0.f}, gx = ga;
                  ga = __builtin_amdgcn_mfma_f32_16x16x32_bf16(wa[cb][0], xf[0], ga, 0, 0, 0); ga = __builtin_amdgcn_mfma_f32_16x16x32_bf16(wa[cb][1], xf[1], ga, 0, 0, 0);
                  gx = __builtin_amdgcn_mfma_f32_16x16x32_bf16(wx[cb][0], xf[0], gx, 0, 0, 0); gx = __builtin_amdgcn_mfma_f32_16x16x32_bf16(wx[cb][1], xf[1], gx, 0, 0, 0);
                  const int d0 = 16 * cb + 4 * fq;
                  const f32x4 ba = *(const LAS f32x4*)(CW + 320 + d0), bx = *(const LAS f32x4*)(CW + 384 + d0), cdv = *(const LAS f32x4*)(CW + 448 + d0);
                  const u32x2 xw = *(const LAS u32x2*)(XCB + fr * 72 + d0);
                  const float xcv[4] = {bflo(xw.x), bfhi(xw.x), bflo(xw.y), bfhi(xw.y)};
                  f32x4 av, uv;
#pragma unroll
                  for (int i = 0; i < 4; ++i) { const float r = sigmoidf_(ga[i] + ba[i]), ig = sigmoidf_(gx[i] + bx[i]); const float aa = __builtin_amdgcn_exp2f(-cdv[i] * r);
                      av[i] = aa; uv[i] = __builtin_amdgcn_sqrtf(fmaxf(1.0f - aa * aa, 0.f)) * (ig * xcv[i]); }
                  *(LAS f32x4*)(AA + fr * 64 + d0) = av; *(LAS f32x4*)(UU + fr * 64 + d0) = uv;
              } }
            asm volatile("s_waitcnt lgkmcnt(0)" ::: "memory");
            if constexpr (FINAL) {
#pragma unroll
                for (int t = 0; t < 16; ++t) { const float av = AA[t * 64 + lane], uv = UU[t * 64 + lane]; hrun = av * hrun + uv; UU[t * 64 + lane] = hrun; }
                asm volatile("s_waitcnt lgkmcnt(0)" ::: "memory");
#pragma unroll
                for (int rr = 0; rr < 2; ++rr) {
                    const f32x4 h0 = *(const LAS f32x4*)(UU + (2 * rp + rr) * 64 + cg * 8), h1 = *(const LAS f32x4*)(UU + (2 * rp + rr) * 64 + cg * 8 + 4);
                    const float hv[8] = {h0[0], h0[1], h0[2], h0[3], h1[0], h1[1], h1[2], h1[3]}; float o[8];
#pragma unroll
                    for (int q = 0; q < 4; ++q)
#pragma unroll
                        for (int hl = 0; hl < 2; ++hl) { const float x = hl ? bfhi(gv[rr][q]) : bflo(gv[rr][q]); const float y = 0.7978845608028654f * (x + 0.044715f * x * x * x);
                            const float th = 1.0f - 2.0f * __builtin_amdgcn_rcpf(1.0f + __expf(2.0f * y)); o[2 * q + hl] = hv[2 * q + hl] * 0.5f * x * (1.0f + th); }
                    u32x4 w; w.x = cvtpk(o[0], o[1]); w.y = cvtpk(o[2], o[3]); w.z = cvtpk(o[4], o[5]); w.w = cvtpk(o[6], o[7]);
                    *(u32x4*)(MIXp + (size_t)(s0 + 2 * rp + rr) * DM) = w;
                }
            } else {
#pragma unroll
                for (int t = 0; t < 16; ++t) { const float av = AA[t * 64 + lane], uv = UU[t * 64 + lane]; Hp = av * Hp + uv; Ap *= av; UU[t * 64 + lane] = Hp; AA[t * 64 + lane] = Ap; }
                asm volatile("s_waitcnt lgkmcnt(0)" ::: "memory");
#pragma unroll
                for (int rr = 0; rr < 2; ++rr) {
                    const f32x4 h0 = *(const LAS f32x4*)(UU + (2 * rp + rr) * 64 + cg * 8), h1 = *(const LAS f32x4*)(UU + (2 * rp + rr) * 64 + cg * 8 + 4);
                    const f32x4 p0 = *(const LAS f32x4*)(AA + (2 * rp + rr) * 64 + cg * 8), p1 = *(const LAS f32x4*)(AA + (2 * rp + rr) * 64 + cg * 8 + 4);
                    u32x4 wh, wp; wh.x = cvtpk(h0[0], h0[1]); wh.y = cvtpk(h0[2], h0[3]); wh.z = cvtpk(h1[0], h1[1]); wh.w = cvtpk(h1[2], h1[3]);
                    wp.x = cvtpk(p0[0], p0[1]); wp.y = cvtpk(p0[2], p0[3]); wp.z = cvtpk(p1[0], p1[1]); wp.w = cvtpk(p1[2], p1[3]);
                    *(u32x4*)(HLp + (size_t)(s0 + 2 * rp + rr) * 512) = wh; *(u32x4*)(PPp + (size_t)(s0 + 2 * rp + rr) * 512) = wp;
                }
            }
            asm volatile("s_waitcnt lgkmcnt(0)" ::: "memory");
        }
        if constexpr (!FINAL) carry[(size_t)c * 512] = (f32x2){Ap, Hp};
    }
}

__device__ __forceinline__ void phase_lrufix(unsigned char* ws, LAS unsigned char* lds, int bid, int G, int tid, int lane, int wave) {
    LAS float* CI = (LAS float*)lds;
    for (int item = bid; item < NB * 32; item += G) {
        const int b = item >> 5, c0 = (item & 31) * 2;
        const f32x2* carry = (const f32x2*)(ws + WS_CARRY) + (size_t)b * 64 * 512 + tid;
        f32x2 cv[64];
#pragma unroll
        for (int cc = 0; cc < 64; ++cc) cv[cc] = carry[(size_t)cc * 512];
        float hrun = 0.f, h1 = 0.f;
#pragma unroll
        for (int cc = 0; cc < 64; ++cc) { if (cc == c0) h1 = hrun; if (cc <= c0) hrun = cv[cc].x * hrun + cv[cc].y; }
        CI[tid] = h1; CI[512 + tid] = hrun;
        __syncthreads();
        float cin[8];
        { const f32x4 c0v = *(const LAS f32x4*)(CI + (wave >> 2) * 512 + lane * 8), c1v = *(const LAS f32x4*)(CI + (wave >> 2) * 512 + lane * 8 + 4);
#pragma unroll
          for (int i = 0; i < 4; ++i) { cin[i] = c0v[i]; cin[4 + i] = c1v[i]; } }
        const size_t row0 = (size_t)b * SEQ + (size_t)c0 * 128 + wave * 32;
        const bf16_t* HLp = (const bf16_t*)(ws + WS_HL) + row0 * 512 + lane * 8; const bf16_t* PPp = (const bf16_t*)(ws + WS_PP) + row0 * 512 + lane * 8;
        const bf16_t* GRp = (const bf16_t*)(ws + WS_Q) + (size_t)4 * MTOK * 512 + row0 * 512 + lane * 8;
        bf16_t* MIXp = (bf16_t*)(ws + WS_MIX) + row0 * DM + 512 + lane * 8;
#pragma unroll 4
        for (int r = 0; r < 32; ++r) {
            const u32x4 hw = __builtin_nontemporal_load((const u32x4*)(HLp + (size_t)r * 512)), pw = __builtin_nontemporal_load((const u32x4*)(PPp + (size_t)r * 512)), gw = __builtin_nontemporal_load((const u32x4*)(GRp + (size_t)r * 512));
            float o[8];
#pragma unroll
            for (int q = 0; q < 4; ++q)
#pragma unroll
                for (int hl = 0; hl < 2; ++hl) { const float hv = (hl ? bfhi(hw[q]) : bflo(hw[q])) + (hl ? bfhi(pw[q]) : bflo(pw[q])) * cin[2 * q + hl];
                    const float x = hl ? bfhi(gw[q]) : bflo(gw[q]); const float y = 0.7978845608028654f * (x + 0.044715f * x * x * x);
                    const float th = 1.0f - 2.0f * __builtin_amdgcn_rcpf(1.0f + __expf(2.0f * y)); o[2 * q + hl] = hv * 0.5f * x * (1.0f + th); }
            u32x4 w; w.x = cvtpk(o[0], o[1]); w.y = cvtpk(o[2], o[3]); w.z = cvtpk(o[4], o[5]); w.w = cvtpk(o[6], o[7]);
            *(u32x4*)(MIXp + (size_t)r * DM) = w;
        }
        __syncthreads();
    }
}

__device__ __forceinline__ s16x4 vtr(const LAS unsigned char* p) { return __builtin_bit_cast(s16x4, __builtin_amdgcn_ds_read_tr16_b64_v4i16((LAS s16x4*)p)); }
__device__ __forceinline__ void glds16(const void* gsrc, unsigned lds_dst) { unsigned keep;
    asm volatile("s_mov_b32 %0, m0\n\ts_mov_b32 m0, %2\n\ts_nop 0\n\tglobal_load_lds_dwordx4 %1, off\n\ts_mov_b32 m0, %0" : "=&s"(keep) : "v"(gsrc), "s"(lds_dst) : "memory"); }
__device__ __forceinline__ int crow(int r, int hi) { return (r & 3) + 8 * (r >> 2) + 4 * hi; }
constexpr int AT_SLOT = 32768, AT_STRIDE = 132;
constexpr int AT_KSLOT = 16384, AT_VBASE = 49152, AT_VSLOT = 16384, AT_WL = RING_BYTES + 1024;
template <bool DOQK, bool DOPV>
__device__ __forceinline__ void attn_step(const LAS unsigned char* kb, const LAS unsigned char* vb, const int (&vad)[4], const int vdl, const bf16x8 (&qf)[4], const f32x16& negsb, f32x16 (&o)[4], bf16x8 (&pa)[2][2], float& lsum, const LAS unsigned char* vbn, s16x4 (&vl)[5], s16x4 (&vh)[5]) {
    f32x16 p0 = negsb, p1 = negsb; bf16x8 kf[4];
#define AT_VRD(g) do { if constexpr (DOPV) { if ((g) < 16) { vl[(g) % 5] = vtr(vb + vad[(g) & 3] + 4096 * ((g) >> 2)); vh[(g) % 5] = vtr(vb + vad[(g) & 3] + vdl + 4096 * ((g) >> 2)); } } } while (0)
#define AT_PVG(g) do { if constexpr (DOPV) { const s16x4 a_ = vl[(g) % 5], b_ = vh[(g) % 5]; const bf16x8 vf_ = (bf16x8){a_[0], a_[1], a_[2], a_[3], b_[0], b_[1], b_[2], b_[3]}; \
        o[(g) & 3] = __builtin_amdgcn_mfma_f32_32x32x16_bf16(pa[(g) >> 3][((g) >> 2) & 1], vf_, o[(g) & 3], 0, 0, 0); } } while (0)
#define AT_KRD(d0) do { if constexpr (DOQK) { kf[2 * ((d0) & 1)] = *(const LAS bf16x8*)(kb + (d0) * 2048); kf[2 * ((d0) & 1) + 1] = *(const LAS bf16x8*)(kb + (d0) * 2048 + 512); } } while (0)
#define AT_QK(d0) do { if constexpr (DOQK) { p0 = __builtin_amdgcn_mfma_f32_32x32x16_bf16(kf[2 * ((d0) & 1)], qf[d0], p0, 0, 0, 0); p1 = __builtin_amdgcn_mfma_f32_32x32x16_bf16(kf[2 * ((d0) & 1) + 1], qf[d0], p1, 0, 0, 0); } } while (0)
    AT_KRD(0); AT_KRD(1);
    __builtin_amdgcn_sched_barrier(0);
    AT_VRD(4); AT_PVG(0); __builtin_amdgcn_sched_barrier(0);
    AT_VRD(5); AT_PVG(1); __builtin_amdgcn_sched_barrier(0);
    AT_VRD(6); AT_PVG(2); __builtin_amdgcn_sched_barrier(0);
    AT_QK(0); AT_KRD(2); __builtin_amdgcn_sched_barrier(0);
    AT_VRD(7); AT_PVG(3); __builtin_amdgcn_sched_barrier(0);
    AT_QK(1); AT_KRD(3); __builtin_amdgcn_sched_barrier(0);
    AT_VRD(8); AT_PVG(4); __builtin_amdgcn_sched_barrier(0);
    AT_VRD(9); AT_PVG(5); __builtin_amdgcn_sched_barrier(0);
    AT_QK(2); AT_QK(3);
    __builtin_amdgcn_sched_barrier(0);
#undef AT_KRD
#undef AT_QK
    float ls = 0.f;
#define AT_EXP(P, i) do { if constexpr (DOQK) { P[i] = __builtin_amdgcn_exp2f(P[i]); ls += P[i]; } } while (0)
    AT_VRD(10); AT_PVG(6);  AT_EXP(p0, 0);  AT_EXP(p0, 1);  AT_EXP(p0, 2);  __builtin_amdgcn_sched_barrier(0);
    AT_VRD(11); AT_PVG(7);  AT_EXP(p0, 3);  AT_EXP(p0, 4);  AT_EXP(p0, 5);  __builtin_amdgcn_sched_barrier(0);
    AT_VRD(12); AT_PVG(8);  AT_EXP(p0, 6);  AT_EXP(p0, 7);  AT_EXP(p0, 8);  __builtin_amdgcn_sched_barrier(0);
    AT_VRD(13); AT_PVG(9);  AT_EXP(p0, 9);  AT_EXP(p0, 10); AT_EXP(p0, 11); __builtin_amdgcn_sched_barrier(0);
    AT_VRD(14); AT_PVG(10); AT_EXP(p0, 12); AT_EXP(p0, 13); AT_EXP(p0, 14); AT_EXP(p0, 15); __builtin_amdgcn_sched_barrier(0);
    AT_VRD(15); AT_PVG(11); AT_EXP(p1, 0);  AT_EXP(p1, 1);  AT_EXP(p1, 2);  AT_EXP(p1, 3);  __builtin_amdgcn_sched_barrier(0);
    AT_PVG(12); AT_EXP(p1, 4);  AT_EXP(p1, 5);  AT_EXP(p1, 6);  __builtin_amdgcn_sched_barrier(0);
    AT_PVG(13); AT_EXP(p1, 7);  AT_EXP(p1, 8);  AT_EXP(p1, 9);  __builtin_amdgcn_sched_barrier(0);
    AT_PVG(14); AT_EXP(p1, 10); AT_EXP(p1, 11); AT_EXP(p1, 12); __builtin_amdgcn_sched_barrier(0);
    AT_PVG(15); AT_EXP(p1, 13); AT_EXP(p1, 14); AT_EXP(p1, 15); __builtin_amdgcn_sched_barrier(0);
    if constexpr (DOPV) {
#pragma unroll
        for (int g = 0; g < 4; ++g) { vl[g] = vtr(vbn + vad[g]); vh[g] = vtr(vbn + vad[g] + vdl); } }
    __builtin_amdgcn_sched_barrier(0);
#undef AT_VRD
#undef AT_PVG
#undef AT_EXP
    if constexpr (DOQK) {
        lsum += ls;
#pragma unroll
        for (int ks = 0; ks < 2; ++ks) { u32x4 w0, w1;
#pragma unroll
            for (int i = 0; i < 4; ++i) { w0[i] = cvtpk(p0[8 * ks + 2 * i], p0[8 * ks + 2 * i + 1]); w1[i] = cvtpk(p1[8 * ks + 2 * i], p1[8 * ks + 2 * i + 1]); }
            pa[0][ks] = __builtin_bit_cast(bf16x8, w0); pa[1][ks] = __builtin_bit_cast(bf16x8, w1); }
    }
}
constexpr int CV_ITEMS1 = NEXP * 64 * 32, CV_ITEMS = CV_ITEMS1 + NEXP * 64 * 16, CV_PER_WAVE = CV_ITEMS / 1024, CV_LDS = 114688;
static_assert(CV_PER_WAVE * 5 <= 520 - 3, "conversion items must fit the attention phase's tile steps");
__device__ __forceinline__ void conv_issue(const Args& a, unsigned ldsbuf, int it, int lane) {
    const bool w1 = it < CV_ITEMS1; const int i2 = w1 ? it : it - CV_ITEMS1;
    const int N = w1 ? 2048 : 1024, lgn = w1 ? 5 : 4, nb = i2 & ((1 << lgn) - 1), kb = (i2 >> lgn) & 63, e = i2 >> (lgn + 6);
    const float* base = (w1 ? a.in[I_W1] : a.in[I_W2]) + ((size_t)e * 1024 + kb * 16) * N + nb * 64;
#pragma unroll
    for (int j = 0; j < 4; ++j) { const int R = 4 * j + (lane >> 4), chunk = (lane & 15) ^ R; glds16(base + (size_t)R * N + chunk * 4, ldsbuf + j * 1024u); }
}
__device__ __forceinline__ void conv_finish(unsigned char* ws, const LAS unsigned char* buf, int it, int lane) {
    const bool w1 = it < CV_ITEMS1; const int i2 = w1 ? it : it - CV_ITEMS1;
    const int lgn = w1 ? 5 : 4, nb = i2 & ((1 << lgn) - 1), kb = (i2 >> lgn) & 63, e = i2 >> (lgn + 6);
    const int c = lane >> 2, e4 = lane & 3;
    float v[16];
#pragma unroll
    for (int r = 0; r < 16; ++r) v[r] = *(const LAS float*)(buf + r * 256 + ((c ^ r) & 15) * 16 + e4 * 4) * WSCALE;
    const float lo[8] = {v[0], v[1], v[2], v[3], v[4], v[5], v[6], v[7]}, hi[8] = {v[8], v[9], v[10], v[11], v[12], v[13], v[14], v[15]};
    const u32x2 p0 = pack_fp8x8(lo), p1 = pack_fp8x8(hi);
    unsigned char* dst = w1 ? (unsigned char*)(ws + WS_W1) + ((size_t)e * 2048 + map_row(2, nb * 64 + lane)) * 1024 + kb * 16
                            : (unsigned char*)(ws + WS_W2) + ((size_t)e * 1024 + nb * 64 + lane) * 1024 + kb * 16;
    *(u32x4*)dst = (u32x4){p0.x, p0.y, p1.x, p1.y};
}
struct ConvState { int ph, n; };
__device__ __forceinline__ void attn_unit2(const Args& a, unsigned char* ws, LAS unsigned char* lds, int b, int h, int qb, int lane, int wave, ConvState& cs, int cw) {
    const bf16_t* Q = (const bf16_t*)(ws + WS_Q); const bf16_t* Kb = Q + (size_t)MTOK * 512; const bf16_t* Vb = Kb + (size_t)MTOK * 512;
    const float* scal = (const float*)(ws + WS_SCAL); const float lam = scal[0], SB = scal[1];
    const int rg = wave >> 1, t = wave & 1, r32 = lane & 31, hi = lane >> 5;
    const size_t tok0 = (size_t)b * SEQ + (size_t)qb * 128;
    bf16x8 qf[4];
    { const bf16_t* qp = Q + (tok0 + rg * 32 + r32) * 512 + (2 * h + t) * 64 + 8 * hi;
#pragma unroll
      for (int d0 = 0; d0 < 4; ++d0) qf[d0] = *(const bf16x8*)(qp + 16 * d0); }
    const int NT = 2 * qb + 2, my_last = 2 * qb + (rg >> 1);
    const unsigned koff0 = (unsigned)((((2 * h) * 8 + wave) * 64 + lane) * 8) * 2u;
    unsigned voff0; { const int row = 4 * wave + (lane >> 4), ch = (lane & 15) ^ (((row & 3) << 2) | ((row >> 2) & 3)); voff0 = (unsigned)((h * 64 + row) * 128 + ch * 8) * 2u; }
    const char* Kt = (const char*)(Kb + (size_t)b * SEQ * 512); const char* Vt = (const char*)(Vb + (size_t)b * SEQ * 512);
    const unsigned ldsb = (unsigned)(uintptr_t)lds + (unsigned)wave * 1024u;
#define AT2_DMA(kt, ks_, vs_) do { const size_t to_ = (size_t)(kt) * 65536; const unsigned kb_ = (unsigned)__builtin_amdgcn_readfirstlane((int)(ldsb + (unsigned)(ks_) * AT_KSLOT)), vb_ = (unsigned)__builtin_amdgcn_readfirstlane((int)(ldsb + AT_VBASE + (unsigned)(vs_) * AT_VSLOT)); \
        glds16(Kt + to_ + koff0, kb_); glds16(Kt + to_ + 8192 + koff0, kb_ + 8192u); glds16(Vt + to_ + voff0, vb_); glds16(Vt + to_ + 8192 + voff0, vb_ + 8192u); } while (0)
    const int blk = (lane >> 4) & 1, qq = (lane & 15) >> 2, pp = lane & 3;
    int vad[4];
#pragma unroll
    for (int c = 0; c < 4; ++c) vad[c] = 256 * (4 * hi + qq) + 8 * (pp & 1) + 16 * ((((c ^ qq) & 3) << 2) | ((2 * blk + (pp >> 1)) ^ hi));
    const int vdl = 2048 + 16 * ((((2 * blk + (pp >> 1)) ^ (2 + hi)) & 3) - (((2 * blk + (pp >> 1)) ^ hi) & 3));
    const int kad = t * 8192 + hi * 1024 + r32 * 16;
    f32x16 o[4];
#pragma unroll
    for (int c = 0; c < 4; ++c)
#pragma unroll
        for (int r = 0; r < 16; ++r) o[c][r] = 0.f;
    float lsum = 0.f;
    f32x16 negsb;
#pragma unroll
    for (int r = 0; r < 16; ++r) negsb[r] = -SB;
    bf16x8 pa[2][2];
#pragma unroll
    for (int i = 0; i < 2; ++i)
#pragma unroll
        for (int j = 0; j < 2; ++j) pa[i][j] = (bf16x8){0, 0, 0, 0, 0, 0, 0, 0};
    AT2_DMA(0, 0, 0); AT2_DMA(1, 1, 1);
    asm volatile("" : "+v"(qf[0]), "+v"(qf[1]), "+v"(qf[2]), "+v"(qf[3]));
    int ksl = 0, vsl = 0, vprev = 0;
    s16x4 vl[5], vh[5];
#pragma unroll
    for (int i = 0; i < 5; ++i) { vl[i] = (s16x4){0, 0, 0, 0}; vh[i] = (s16x4){0, 0, 0, 0}; }
    for (int kt = 0; kt <= NT; ++kt) {
        if (kt < NT) {
            if (kt + 1 < NT) asm volatile("s_waitcnt vmcnt(4)" ::: "memory"); else asm volatile("s_waitcnt vmcnt(0)" ::: "memory");
            __builtin_amdgcn_s_barrier();
            asm volatile("" ::: "memory");
            if (wave < 4 && cw >= 0) {
                if (cs.n < CV_PER_WAVE) {
                    if (cs.ph == 0) conv_issue(a, (unsigned)__builtin_amdgcn_readfirstlane((int)((unsigned)(uintptr_t)lds + CV_LDS + wave * 4096)), cs.n * 1024 + cw, lane);
                    else if (cs.ph == 2) { conv_finish(ws, lds + CV_LDS + wave * 4096, cs.n * 1024 + cw, lane); ++cs.n; }
                }
                cs.ph = cs.ph == 4 ? 0 : cs.ph + 1;
            }
            if (kt + 2 < NT) { const int k2 = ksl >= 1 ? ksl - 1 : 2, v2 = (vsl + 2) & 3; AT2_DMA(kt + 2, k2, v2); }
            if (kt == 0) {
#pragma unroll
                for (int g = 0; g < 4; ++g) { vl[g] = vtr(lds + AT_VBASE + vad[g]); vh[g] = vtr(lds + AT_VBASE + vad[g] + vdl); } }
        }
        const LAS unsigned char* kb = lds + ksl * AT_KSLOT + kad; const LAS unsigned char* vb = lds + AT_VBASE + vprev * AT_VSLOT;
        if (kt <= my_last + 1) { float ls = 0.f; attn_step<true, true>(kb, vb, vad, vdl, qf, negsb, o, pa, ls, lds + AT_VBASE + vsl * AT_VSLOT, vl, vh); lsum += (kt <= my_last) ? ls : 0.f; }
        vprev = vsl; ksl = ksl == 2 ? 0 : ksl + 1; vsl = (vsl + 1) & 3;
    }
#undef AT2_DMA
    lsum += __shfl_xor(lsum, 32);
    asm volatile("s_waitcnt lgkmcnt(0)" ::: "memory"); __builtin_amdgcn_s_barrier(); asm volatile("" ::: "memory");
    LAS float* wl = (LAS float*)(lds + AT_WL) + wave * 32;
    if (hi == 0) wl[r32] = lsum;
    asm volatile("s_waitcnt lgkmcnt(0)" ::: "memory");
    float linv[16];
#pragma unroll
    for (int r = 0; r < 16; ++r) linv[r] = (t ? lam : 1.0f) / wl[crow(r, hi)];
    LAS float* ST = (LAS float*)lds + rg * (32 * AT_STRIDE);
    if (t == 1) {
#pragma unroll
        for (int c = 0; c < 4; ++c)
#pragma unroll
            for (int r = 0; r < 16; ++r) ST[crow(r, hi) * AT_STRIDE + 32 * c + r32] = o[c][r] * linv[r];
    }
    asm volatile("s_waitcnt lgkmcnt(0)" ::: "memory"); __builtin_amdgcn_s_barrier(); asm volatile("" ::: "memory");
    if (t == 0) {
#pragma unroll
        for (int c = 0; c < 4; ++c)
#pragma unroll
            for (int r = 0; r < 16; ++r) { const int ad = crow(r, hi) * AT_STRIDE + 32 * c + r32; ST[ad] = o[c][r] * linv[r] - ST[ad]; }
    }
    asm volatile("s_waitcnt lgkmcnt(0)" ::: "memory"); __builtin_amdgcn_s_barrier(); asm volatile("" ::: "memory");
    {
        const int row = 16 * t + (lane >> 2), dseg = lane & 3;
        const LAS f32x4* rp = (const LAS f32x4*)(ST + row * AT_STRIDE + dseg * 32);
        f32x4 v[8]; float ss = 0.f;
#pragma unroll
        for (int i = 0; i < 8; ++i) { v[i] = rp[i]; ss += (v[i][0] * v[i][0] + v[i][1] * v[i][1]) + (v[i][2] * v[i][2] + v[i][3] * v[i][3]); }
        ss += __shfl_xor(ss, 1); ss += __shfl_xor(ss, 2);
        const float rs = 0.8f / sqrtf(ss * (1.0f / 128.0f) + 1e-5f);
        const f32x4* gp = (const f32x4*)(a.in[I_SUBG] + dseg * 32);
        bf16_t* op = (bf16_t*)(ws + WS_MIX) + (tok0 + rg * 32 + row) * DM + h * 128 + dseg * 32;
#pragma unroll
        for (int i = 0; i < 4; ++i) { const f32x4 g0 = gp[2 * i], g1 = gp[2 * i + 1]; const f32x4 x0 = v[2 * i] * rs * g0, x1 = v[2 * i + 1] * rs * g1;
            u32x4 w; w.x = cvtpk(x0[0], x0[1]); w.y = cvtpk(x0[2], x0[3]); w.z = cvtpk(x1[0], x1[1]); w.w = cvtpk(x1[2], x1[3]); *(u32x4*)(op + 8 * i) = w; }
    }
    asm volatile("s_waitcnt lgkmcnt(0)" ::: "memory"); __builtin_amdgcn_s_barrier(); asm volatile("" ::: "memory");
}

#define TOPK_INS(v, i, LEX) do { const float v_ = (v); const int i_ = (i); \
    const bool c3_ = v_ > tv3 || (LEX && v_ == tv3 && i_ < ti3), c2_ = v_ > tv2 || (LEX && v_ == tv2 && i_ < ti2), c1_ = v_ > tv1 || (LEX && v_ == tv1 && i_ < ti1), c0_ = v_ > tv0 || (LEX && v_ == tv0 && i_ < ti0); \
    tv3 = c2_ ? tv2 : (c3_ ? v_ : tv3); ti3 = c2_ ? ti2 : (c3_ ? i_ : ti3); tv2 = c1_ ? tv1 : (c2_ ? v_ : tv2); ti2 = c1_ ? ti1 : (c2_ ? i_ : ti2); \
    tv1 = c0_ ? tv0 : (c1_ ? v_ : tv1); ti1 = c0_ ? ti0 : (c1_ ? i_ : ti1); tv0 = c0_ ? v_ : tv0; ti0 = c0_ ? i_ : ti0; } while (0)
__device__ __forceinline__ void phase_router(const Args& a, unsigned char* ws, LAS unsigned char* lds, int bid, int G, int tid, int lane, int wave) {
    LAS unsigned char* up = lds + RING_BYTES + 1024;
    LAS float* A2 = (LAS float*)up; LAS float* SH = A2 + DM; LAS float* CV = SH + DM; LAS int* hist = (LAS int*)(CV + 32); LAS int* basev = hist + 32; LAS int* er = basev + 32;
    const float* modv = (const float*)(ws + WS_MODV); const bf16_t* x1 = (const bf16_t*)(ws + WS_X1); const float* ssq = (const float*)(ws + WS_SS);
    unsigned* cnt = (unsigned*)(ws + WS_CTL) + CW_CNT; unsigned char* XN = (unsigned char*)(ws + WS_XN);
    for (int tile = bid; tile < MTOK / 256; tile += G) {
        const int b = tile >> 5;
        for (int col = tid; col < DM; col += 512) { A2[col] = a.in[I_N2G][col] * (1.0f + modv[(size_t)b * 6144 + 4 * DM + col]); SH[col] = modv[(size_t)b * 6144 + 3 * DM + col]; }
        if (tid < 32) hist[tid] = 0;
        __syncthreads();
        if (tid < 32) CV[tid] = a.in[I_BR][tid];
        __syncthreads();
        const int r32 = lane & 31, hi = lane >> 5, rl = wave * 32 + r32; const size_t row = (size_t)tile * 256 + rl;
        float ss = 0.f;
        { const f32x4* sp = (const f32x4*)(ssq + row * 16);
#pragma unroll
          for (int i = 0; i < 4; ++i) { const f32x4 v = sp[i]; ss += (v[0] + v[1]) + (v[2] + v[3]); } }
        const float rstd = 1.0f / sqrtf(ss * (1.0f / DM) + 1e-6f);
        const int lr = lane >> 4, ls = lane & 15;
        LAS float* rsT = (LAS float*)(up + 13696) + wave * 32; if (hi == 0) rsT[r32] = rstd;
        LAS float* xs = (LAS float*)(lds + wave * 8192);
        asm volatile("s_waitcnt lgkmcnt(0)" ::: "memory");
        const char* xbase = (const char*)(x1 + ((size_t)tile * 256 + wave * 32) * DM); unsigned char* hbase = XN + ((size_t)tile * 256 + wave * 32) * DM;
        const unsigned xlo = (unsigned)(lr * DM + 4 * ls) * 2u, hlo = (unsigned)(lr * DM + 4 * ls);
        const u32x4* wfr = (const u32x4*)(ws + WS_WRF) + lane;
        u32x2 cx[8], nx[8];
#pragma unroll
        for (int j = 0; j < 8; ++j) cx[j] = *(const u32x2*)(xbase + (size_t)(4 * j) * DM * 2 + xlo);
        f32x16 acc;
#pragma unroll
        for (int r = 0; r < 16; ++r) acc[r] = 0.f;
        for (int i = 0; i < 16; ++i) {
            const int inx = i < 15 ? i + 1 : 15;
#pragma unroll
            for (int j = 0; j < 8; ++j) nx[j] = *(const u32x2*)(xbase + ((size_t)(4 * j) * DM + 64 * inx) * 2 + xlo);
            u32x4 wh4[4], wl4[4];
#pragma unroll
            for (int sI = 0; sI < 4; ++sI) { wh4[sI] = wfr[(4 * i + sI) * 64]; wl4[sI] = wfr[4096 + (4 * i + sI) * 64]; }
            const f32x4 a2v = *(const LAS f32x4*)(A2 + 64 * i + 4 * ls), shv = *(const LAS f32x4*)(SH + 64 * i + 4 * ls);
#pragma unroll
            for (int j = 0; j < 8; ++j) { const int rr = 4 * j + lr; const f32x4 xf = (f32x4){bflo(cx[j].x), bfhi(cx[j].x), bflo(cx[j].y), bfhi(cx[j].y)}; const f32x4 hm = xf * rsT[rr] * a2v + shv;
                int w8 = 0; w8 = __builtin_amdgcn_cvt_pk_fp8_f32(hm[0], hm[1], w8, false); w8 = __builtin_amdgcn_cvt_pk_fp8_f32(hm[2], hm[3], w8, true);
                *(unsigned*)(hbase + (size_t)(4 * j) * DM + 64 * i + hlo) = (unsigned)w8;
                *(LAS f32x4*)(xs + rr * 64 + ((ls ^ (rr & 15)) * 4)) = hm; }
            asm volatile("s_waitcnt lgkmcnt(0)" ::: "memory");
#pragma unroll
            for (int sI = 0; sI < 4; ++sI) {
                const int c0 = 4 * sI + 2 * hi;
                const f32x4 ha = *(const LAS f32x4*)(xs + r32 * 64 + ((c0 ^ (r32 & 15)) * 4)), hb = *(const LAS f32x4*)(xs + r32 * 64 + (((c0 + 1) ^ (r32 & 15)) * 4));
                u32x4 wh; wh.x = cvtpk(ha[0], ha[1]); wh.y = cvtpk(ha[2], ha[3]); wh.z = cvtpk(hb[0], hb[1]); wh.w = cvtpk(hb[2], hb[3]);
                u32x4 wl2; wl2.x = cvtpk(ha[0] - bflo(wh.x), ha[1] - bfhi(wh.x)); wl2.y = cvtpk(ha[2] - bflo(wh.y), ha[3] - bfhi(wh.y)); wl2.z = cvtpk(hb[0] - bflo(wh.z), hb[1] - bfhi(wh.z)); wl2.w = cvtpk(hb[2] - bflo(wh.w), hb[3] - bfhi(wh.w));
                const bf16x8 fh = __builtin_bit_cast(bf16x8, wh), fl = __builtin_bit_cast(bf16x8, wl2), wfh = __builtin_bit_cast(bf16x8, wh4[sI]), wfl = __builtin_bit_cast(bf16x8, wl4[sI]);
                acc = __builtin_amdgcn_mfma_f32_32x32x16_bf16(wfh, fh, acc, 0, 0, 0); acc = __builtin_amdgcn_mfma_f32_32x32x16_bf16(wfl, fh, acc, 0, 0, 0); acc = __builtin_amdgcn_mfma_f32_32x32x16_bf16(wfh, fl, acc, 0, 0, 0);
            }
            asm volatile("s_waitcnt lgkmcnt(0)" ::: "memory");
#pragma unroll
            for (int j = 0; j < 8; ++j) cx[j] = nx[j];
        }
        float tv0 = -INFINITY, tv1 = -INFINITY, tv2 = -INFINITY, tv3 = -INFINITY; int ti0 = 0, ti1 = 0, ti2 = 0, ti3 = 0;
#pragma unroll
        for (int r = 0; r < 16; ++r) { const int e = (r & 3) + 8 * (r >> 2) + 4 * hi; TOPK_INS(acc[r] + CV[e], e, false); }
        { const float p0 = __shfl_xor(tv0, 32), p1 = __shfl_xor(tv1, 32), p2 = __shfl_xor(tv2, 32), p3 = __shfl_xor(tv3, 32); const int q0 = __shfl_xor(ti0, 32), q1 = __shfl_xor(ti1, 32), q2 = __shfl_xor(ti2, 32), q3 = __shfl_xor(ti3, 32);
          TOPK_INS(p0, q0, true); TOPK_INS(p1, q1, true); TOPK_INS(p2, q2, true); TOPK_INS(p3, q3, true); }
        if (hi == 0) { const float e1 = expf(tv1 - tv0), e2 = expf(tv2 - tv0), e3 = expf(tv3 - tv0); const float inv = 1.0f / (1.0f + e1 + e2 + e3);
            *(f32x4*)((float*)(ws + WS_GATE) + row * 4) = (f32x4){inv, e1 * inv, e2 * inv, e3 * inv};
            er[rl * 4 + 0] = ti0 | (atomicAdd((int*)&hist[ti0], 1) << 5); er[rl * 4 + 1] = ti1 | (atomicAdd((int*)&hist[ti1], 1) << 5);
            er[rl * 4 + 2] = ti2 | (atomicAdd((int*)&hist[ti2], 1) << 5); er[rl * 4 + 3] = ti3 | (atomicAdd((int*)&hist[ti3], 1) << 5); }
        __syncthreads();
        if (tid < 32) basev[tid] = (int)atomicAdd(&cnt[tid], (unsigned)hist[tid]);
        __syncthreads();
        for (int i = tid; i < 1024; i += 512) { const int v = er[i], e = v & 31; ((int*)(ws + WS_TOPI))[(size_t)tile * 1024 + i] = e; ((int*)(ws + WS_POS))[(size_t)tile * 1024 + i] = basev[e] + (v >> 5); }
        __syncthreads();
    }
}

__device__ __forceinline__ void phase_fill(const Args& a, LAS unsigned char* lds, int bid, int G, int tid) {
    unsigned char* ws = a.ws;
    LAS int* pst = (LAS int*)lds; LAS int* cn = pst + 32;
    const unsigned* cnt = (const unsigned*)(ws + WS_CTL) + CW_CNT;
    int* rowtok = (int*)(ws + WS_ROWTOK); float* rowg = (float*)(ws + WS_ROWG); int* tinfo = (int*)(ws + WS_TILE);
    if (tid < 32) cn[tid] = (int)cnt[tid];
    __syncthreads();
    if (tid == 0) { int sacc = 0; for (int e = 0; e < 32; ++e) { pst[e] = sacc; sacc += (cn[e] + 255) & ~255; } }
    __syncthreads();
    for (int tile = bid; tile < MTOK / 256; tile += G) {
        for (int i = tid; i < 1024; i += 512) { const size_t k = (size_t)tile * 1024 + i; const int e = ((const int*)(ws + WS_TOPI))[k]; const int pos = pst[e] + ((const int*)(ws + WS_POS))[k];
            ((int*)(ws + WS_POS))[k] = pos; rowtok[pos] = (int)(k >> 2); rowg[pos] = ((const float*)(ws + WS_GATE))[k]; }
    }
    for (int e = bid; e < 32; e += G) { const int s0 = pst[e] + cn[e], s1 = pst[e] + ((cn[e] + 255) & ~255);
        for (int r = s0 + tid; r < s1; r += 512) { rowtok[r] = 0; rowg[r] = 0.f; } }
    if (bid == 0) {
        for (int e = tid; e < 32; e += 512) { const int t0 = pst[e] >> 8, t1 = (pst[e] + ((cn[e] + 255) & ~255)) >> 8; for (int t = t0; t < t1; ++t) tinfo[16 + t] = e; }
        if (tid == 0) tinfo[0] = (pst[31] + ((cn[31] + 255) & ~255)) >> 8;
    }
}

__device__ __forceinline__ void phase_combine(const Args& a, int bid, int G, int lane, int wave, float gmul = 1.0f) {
    unsigned char* ws = a.ws;
    const unsigned char* Y = (const unsigned char*)(ws + WS_Y); const int* posv = (const int*)(ws + WS_POS); const float* modv = (const float*)(ws + WS_MODV);
    for (int rt = bid; rt < MTOK / 128; rt += G) {
        const size_t rbase = (size_t)rt * 128 + wave * 16; const int b = (int)(rbase >> 13);
        f32x4 g2[4];
#pragma unroll
        for (int j = 0; j < 4; ++j) g2[j] = *(const f32x4*)(modv + (size_t)b * 6144 + 5 * DM + 4 * lane + 256 * j) * (YINV * gmul);
        for (int r = 0; r < 16; ++r) {
            const size_t row = rbase + r;
            int ps[4];
#pragma unroll
            for (int j = 0; j < 4; ++j) ps[j] = posv[row * 4 + j];
            f32x4 sacc[4];
#pragma unroll
            for (int q = 0; q < 4; ++q) sacc[q] = (f32x4){0.f, 0.f, 0.f, 0.f};
#pragma unroll
            for (int j = 0; j < 4; ++j) { const unsigned* yp = (const unsigned*)(Y + (size_t)ps[j] * DM) + lane;
#pragma unroll
                for (int q = 0; q < 4; ++q) { const unsigned w = __builtin_nontemporal_load(yp + 64 * q); const f32x2 lo = __builtin_amdgcn_cvt_pk_f32_fp8((int)w, false), hi = __builtin_amdgcn_cvt_pk_f32_fp8((int)w, true);
                    sacc[q][0] += lo[0]; sacc[q][1] += lo[1]; sacc[q][2] += hi[0]; sacc[q][3] += hi[1]; } }
            const u32x2* xp = (const u32x2*)((const bf16_t*)(ws + WS_X1) + row * DM) + lane; f32x4* op = (f32x4*)(a.out + row * DM) + lane;
#pragma unroll
            for (int q = 0; q < 4; ++q) { const u32x2 xw = __builtin_nontemporal_load(xp + 64 * q); const f32x4 xv = (f32x4){bflo(xw.x), bfhi(xw.x), bflo(xw.y), bfhi(xw.y)};
                __builtin_nontemporal_store(xv + g2[q] * sacc[q], op + 64 * q); }
        }
    }
}

__global__ void __launch_bounds__(NWAVES * 64, 2) fwd_kernel(Args args) {
    extern __shared__ __attribute__((aligned(16))) unsigned char lds_raw[];
    LAS unsigned char* lds = (LAS unsigned char*)lds_raw;
    const int G = gridDim.x, bid = blockIdx.x;
    volatile LAS unsigned* MISC = (volatile LAS unsigned*)(lds + LDSCTL_OFF);
    for (int u = threadIdx.x; u < 16; u += NWAVES * 64) MISC[u] = 0u;
    __syncthreads();
    XcdBarrier bar; bar.bar = (unsigned*)(args.ws + WS_CTL) + CW_BAR; bar.x = 0; bar.st = nullptr;
    if (N_LAUNCHES == 1) bar = xcd_barrier_post((unsigned*)(args.ws + WS_CTL) + CW_BAR, MISC + 2);
    const int lo = args.ph_lo, hi = args.ph_hi;
#ifndef PH_MASK
#define PH_MASK 0x7ff
#endif
#define IN(k) (((PH_MASK >> (k)) & 1) && lo <= (k) && (k) < hi)
#ifndef REP_MASK
#define REP_MASK 0
#endif
#define REPS(k) for (int rep_ = 0; rep_ < (((REP_MASK >> (k)) & 1) ? 2 : 1); ++rep_, __syncthreads())
#define SEAM(k) do { if (IN(k) && IN((k) + 1)) xcd_barrier(bar); } while (0)
#define PHASE_VARS int tid = threadIdx.x; asm volatile("" : "+v"(tid)); const int lane = tid & 63, wave = __builtin_amdgcn_readfirstlane(tid >> 6); unsigned char* ws = args.ws; { size_t z_ = 0; asm volatile("" : "+s"(z_)); ws += z_; } (void)lane; (void)wave; (void)ws;

    if (IN(0)) REPS(0) { PHASE_VARS phase_mod(args, lds, bid, G, tid, lane, wave); } SEAM(0);
    if (IN(1)) REPS(1) { PHASE_VARS phase_hn(args, lds, bid, G, tid, lane, wave); phase_misc(args, lds, bid, G, tid, lane, wave); if (G != 256) convert_expert_weights(args, lds, bid, G, lane, wave); } SEAM(1);
    if (IN(2)) REPS(2) {
        PHASE_VARS
        pg8::StaticOrder S; S.init(MTOK, INW, DM, G, bid, ws + WS_XN, ws + WS_WIN);
        EpiInProj E{(bf16_t*)(ws + WS_Q), args.in[I_QG], args.in[I_KG], (const float*)(ws + WS_ROPE), (const float*)(ws + WS_ROPE) + SEQ * 32};
        pg8::gemm_phase<EpiInProj, pg8::StaticOrder, false, true>(lds, DM, S, E);
    } SEAM(2);
    if (IN(3)) REPS(3) {
        PHASE_VARS
        for (int gw = bid * NWAVES + wave; gw < 2048; gw += G * NWAVES) lru_wave<false>(args, ws, lds + wave * LRU_WAVE_LDS, gw >> 8, (gw >> 5) & 7, (gw & 31) * 2, 2, lane);
        __syncthreads();
        {
            const int nu = (G == 256) ? 8 : (NB * 4 * 64 - bid + G - 1) / G;
            ConvState cs{0, 0};
            if (wave >= 4) __builtin_amdgcn_s_setprio(1);
            for (int u = 0; u < nu; ++u) { int bh, qb;
                if (G == 256) { bh = 4 * (bid & 7) + (u >> 1); qb = (u & 1) ? (bid >> 3) : 63 - (bid >> 3); } else { const int uu = bid + u * G; bh = uu >> 6; qb = 63 - (uu & 63); }
                attn_unit2(args, ws, lds, bh >> 2, bh & 3, qb, lane, wave, cs, (G == 256) ? bid * 4 + wave : -1); }
            __builtin_amdgcn_s_setprio(0);
        }
    } SEAM(3);
    if (IN(4)) REPS(4) { PHASE_VARS phase_lrufix(ws, lds, bid, G, tid, lane, wave); } SEAM(4);
    if (IN(5)) REPS(5) {
        PHASE_VARS
        pg8::StaticOrder S; S.init(MTOK, DM, DM, G, bid, ws + WS_MIX, ws + WS_WOUT);
        EpiOutProj E{args.in[I_X], (bf16_t*)(ws + WS_X1), (const float*)(ws + WS_MODV), (float*)(ws + WS_SS)};
        pg8::gemm_phase<EpiOutProj, pg8::StaticOrder, false, true>(lds, DM, S, E);
    } SEAM(5);
    if (IN(6)) { PHASE_VARS phase_router(args, ws, lds, bid, G, tid, lane, wave); } SEAM(6);
    if (IN(7)) { PHASE_VARS phase_fill(args, lds, bid, G, tid); } SEAM(7);
    if (IN(8) || IN(9)) {
        PHASE_VARS
        const int* tinfo = (const int*)(ws + WS_TILE); LAS int* tl = (LAS int*)(lds + LDS_TILE_OFF);
        const int ntl = tinfo[0]; for (int t = tid; t < ntl; t += NWAVES * 64) tl[t] = tinfo[16 + t];
        __syncthreads();
    }
    if (IN(8)) REPS(8) {
        PHASE_VARS
        const int* tinfo = (const int*)(ws + WS_TILE);
        MoeOrder S{bid, 3, (G >> 3) >> 3, tinfo[0], (const LAS int*)(lds + LDS_TILE_OFF), (const int*)(ws + WS_ROWTOK), (const char*)(ws + WS_XN), 0, (const char*)(ws + WS_W1), (size_t)2048 * DM, (size_t)256 * DM, args.in[I_B1], 2048, 128, nullptr};
        EpiMoe1 E{(unsigned char*)(ws + WS_ACT), args.in[I_B1]};
        pg8::gemm_phase<EpiMoe1, MoeOrder, true, true, true>(lds, DM / 2, S, E, (LAS int*)(lds + LDS_ROWL_OFF), (LAS float*)(lds + LDS_AUX_OFF));
    } SEAM(8);
    if (IN(9)) REPS(9) {
        PHASE_VARS
        const int* tinfo = (const int*)(ws + WS_TILE);
        MoeOrder S{bid, 2, (G >> 3) >> 2, tinfo[0], (const LAS int*)(lds + LDS_TILE_OFF), (const int*)(ws + WS_ROWTOK), (const char*)(ws + WS_ACT), (size_t)256 * DFF, (const char*)(ws + WS_W2), (size_t)DM * DFF, (size_t)256 * DFF, args.in[I_B2], 1024, 256, (const float*)(ws + WS_ROWG)};
        EpiMoe2 E{(unsigned char*)(ws + WS_Y), args.in[I_B2], (const float*)(ws + WS_ROWG)};
        pg8::gemm_phase<EpiMoe2, MoeOrder, false, true, true>(lds, DFF / 2, S, E, nullptr, (LAS float*)(lds + LDS_AUX_OFF));
    } SEAM(9);
    if (IN(10)) { PHASE_VARS phase_combine(args, bid, G, lane, wave);
#if defined(PROBE_COMBINE)
        __syncthreads(); phase_combine(args, bid, G, lane, wave, 0.0f);
#endif
    }
#undef IN
#undef SEAM
#undef PHASE_VARS
}

extern "C" void kernel_launch(void* const* d_in, const int* in_sizes, int n_in, void* d_out, int out_size, void* d_ws, size_t ws_size, hipStream_t stream) {
    static int grid = 0;
    if (grid == 0) {
        if (n_in != 28 || in_sizes[0] != MTOK * DM || out_size != MTOK * DM || ws_size < WS_END) { fprintf(stderr, "kernel_launch: unexpected shapes (n_in %d, ws %zu)\n", n_in, ws_size); grid = -1; return; }
        int dev = 0, cus = 0, per_cu = 0;
        if (hipGetDevice(&dev) != hipSuccess || hipDeviceGetAttribute(&cus, hipDeviceAttributeMultiprocessorCount, dev) != hipSuccess) { grid = -1; return; }
        if (hipFuncSetAttribute((const void*)fwd_kernel, hipFuncAttributeMaxDynamicSharedMemorySize, LDS_BYTES) != hipSuccess) { fprintf(stderr, "kernel_launch: hipFuncSetAttribute failed\n"); grid = -1; return; }
        if (hipOccupancyMaxActiveBlocksPerMultiprocessor(&per_cu, (const void*)fwd_kernel, NWAVES * 64, LDS_BYTES) != hipSuccess || per_cu < 1) fprintf(stderr, "kernel_launch: occupancy query reports %d\n", per_cu);
        (void)hipGetLastError();
        grid = cus;
    }
    if (grid < 0) return;
    if (hipMemsetAsync((char*)d_ws + WS_CTL, 0, CTL_ZERO_BYTES, stream) != hipSuccess) return;
    Args a{};
    for (int i = 0; i < 28; ++i) a.in[i] = (const float*)d_in[i];
    a.out = (float*)d_out; a.ws = (unsigned char*)d_ws;
    for (int li = 0; li < N_LAUNCHES; ++li) {
        a.ph_lo = (N_LAUNCHES == 1) ? 0 : li; a.ph_hi = (N_LAUNCHES == 1) ? NPHASE : li + 1;
        hipLaunchKernelGGL(fwd_kernel, dim3(grid), dim3(NWAVES * 64), LDS_BYTES, stream, a);
    }
}
```

```cpp
#include <hip/hip_runtime.h>
#include <cstdio>
#include <cstdint>

#define LAS __attribute__((address_space(3)))
#define GAS __attribute__((address_space(1)))
typedef unsigned short bf16_t;
typedef short bf16x8 __attribute__((ext_vector_type(8)));
typedef float f32x4 __attribute__((ext_vector_type(4)));
typedef float f32x2 __attribute__((ext_vector_type(2)));
typedef unsigned u32x4 __attribute__((ext_vector_type(4)));
typedef unsigned u32x2 __attribute__((ext_vector_type(2)));

#ifndef MK_N_LAUNCHES
#define MK_N_LAUNCHES 1
#endif

constexpr int NB = 8, SEQ = 8192, DM = 1024, MTOK = NB * SEQ;
constexpr int INW = 2560, AW = 512;
constexpr int NEXP = 32, DFF = 1024;
constexpr int HR = MTOK * 4 + NEXP * 256;
constexpr int MAXT = HR / 256;
constexpr float C2 = 0.125f * 1.4426950408889634f;
constexpr int NPHASE = 11;
constexpr int N_LAUNCHES = MK_N_LAUNCHES;
constexpr int NWAVES = 8;

constexpr size_t MiB = 1u << 20;
constexpr size_t WS_CTL = 0, CTL_ZERO_BYTES = 1 * MiB;
constexpr size_t WS_MODP = 1 * MiB;
constexpr size_t WS_MODV = 3 * MiB;
constexpr size_t WS_ROPE = 4 * MiB;
constexpr size_t WS_SCAL = 6 * MiB;
constexpr size_t WS_WGT = 6 * MiB + 65536;
constexpr size_t WS_CARRY = 8 * MiB;
constexpr size_t WS_TOPI = 10 * MiB, WS_GATE = 11 * MiB, WS_POS = 12 * MiB;
constexpr size_t WS_ROWTOK = 13 * MiB, WS_ROWG = 15 * MiB;
constexpr size_t WS_TILE = 17 * MiB + 512 * 1024;
constexpr size_t WS_SS = 18 * MiB;
constexpr size_t WS_WRF = 22 * MiB + 512 * 1024;
constexpr size_t WS_WIN = 24 * MiB, WS_WOUT = 29 * MiB;
constexpr size_t WS_W2 = 32 * MiB, WS_W1 = 96 * MiB, WS_XN = 224 * MiB;
constexpr size_t WS_Q = 352 * MiB;
constexpr size_t WS_MIX = 672 * MiB;
constexpr size_t WS_ACT = 352 * MiB;
constexpr size_t WS_Y = 624 * MiB;
constexpr size_t WS_X1 = 888 * MiB;
constexpr size_t WS_HL = 888 * MiB, WS_PP = 952 * MiB;
constexpr size_t WS_END = 1024 * MiB;
static_assert(WS_ACT + (size_t)HR * 1024 <= WS_Y && WS_Y + (size_t)HR * 1024 <= WS_X1 && WS_X1 + (size_t)MTOK * DM * 2 <= WS_END && (size_t)HR * 4 <= 2 * MiB, "ws map");
constexpr int CW_BAR = 4096;
constexpr int CW_CNT = 16384;
constexpr int CW_HO = 28672;

constexpr int RING_BYTES = 131072;
constexpr int LDSCTL_OFF = RING_BYTES;
constexpr int LDS_TILE_OFF = RING_BYTES + 1024;
constexpr int LDS_ROWL_OFF = RING_BYTES + 6144;
constexpr int LDS_AUX_OFF = RING_BYTES + 8192;
constexpr int LDS_BYTES = 147456;

__device__ __forceinline__ unsigned cvt_pk_bf16(float lo, float hi) { unsigned r; asm volatile("v_cvt_pk_bf16_f32 %0, %1, %2" : "=v"(r) : "v"(lo), "v"(hi)); return r; }
typedef float f32x16 __attribute__((ext_vector_type(16)));
typedef short s16x4 __attribute__((ext_vector_type(4)));
typedef __bf16 bf16x2_t __attribute__((ext_vector_type(2)));
__device__ __forceinline__ unsigned cvtpk(float lo, float hi) { f32x2 v = {lo, hi}; bf16x2_t b = __builtin_convertvector(v, bf16x2_t); return __builtin_bit_cast(unsigned, b); }
__device__ __forceinline__ float bf2f(unsigned short h) { return __uint_as_float(((unsigned)h) << 16); }
__device__ __forceinline__ float bflo(unsigned w) { return __uint_as_float(w << 16); }
__device__ __forceinline__ float bfhi(unsigned w) { return __uint_as_float(w & 0xffff0000u); }
__device__ __forceinline__ float wave_sum(float v) {
#pragma unroll
    for (int o = 1; o < 64; o <<= 1) v += __shfl_xor(v, o);
    return v;
}
__device__ __forceinline__ float wave_max(float v) {
#pragma unroll
    for (int o = 1; o < 64; o <<= 1) v = fmaxf(v, __shfl_xor(v, o));
    return v;
}
__device__ __forceinline__ float sigmoidf_(float z) { return __builtin_amdgcn_rcpf(1.0f + __expf(-z)); }
#define LDS_WAIT() asm volatile("s_waitcnt lgkmcnt(0)" ::: "memory")
#define VM_WAIT() asm volatile("s_waitcnt vmcnt(0)" ::: "memory")

namespace pg8 {
constexpr int BM = 256, BK = 64, HALF = 128, HTB = HALF * BK * 2, STAGE_BYTES = 8 * HTB, NXCD = 8, WGM = 8;
__host__ __device__ __forceinline__ int lds_byte(int r, int c) { const int st = (r >> 4) * 2 + (c >> 5), rr = r & 15, cc = c & 31, ob = rr * 64 + cc * 2; return st * 1024 + (ob ^ (((ob >> 9) & 1) << 5)); }
__host__ __device__ __forceinline__ void stage_rc(int b, int& R, int& C) { const int st = b / 1024, sb = b % 1024, swz = sb ^ (((sb >> 9) & 1) << 5); R = (st >> 1) * 16 + swz / 64; C = (st & 1) * 32 + (swz % 64) / 2; }
__host__ __device__ __forceinline__ int perm32(int rho) { const int n = rho >> 4, i = rho & 15; return 8 * (i >> 2) + 4 * n + (i & 3); }

struct Unit { int pm, pn, e; const char* A; const char* B; const int* rows; };

struct StaticOrder {
    int nM, nN, nwg, G, c; const char* A; const char* Bt; size_t tstep;
    __device__ void init(int M, int N, int K, int G_, int c_, const void* A_, const void* Bt_) { nM = M / BM; nN = N / BM; nwg = nM * nN; G = G_; c = c_; A = (const char*)A_; Bt = (const char*)Bt_; tstep = (size_t)BM * K * 2; }
    __device__ bool next(int i, Unit& u) const {
        const long L = (long)i * G + c; if (L >= nwg) return false;
        int wgid = (int)L; { const int q = nwg / NXCD, r = nwg % NXCD, xcd = wgid % NXCD, off = wgid / NXCD; wgid = (xcd < r ? xcd * (q + 1) : r * (q + 1) + (xcd - r) * q) + off; }
        const int nig = WGM * nN, gid = wgid / nig, fm = gid * WGM, gsz = (nM - fm) < WGM ? (nM - fm) : WGM;
        u.pm = fm + ((wgid % nig) % gsz); u.pn = (wgid % nig) / gsz; u.e = 0; u.A = A + (size_t)u.pm * tstep; u.B = Bt + (size_t)u.pn * tstep; u.rows = nullptr; return true;
    }
    __device__ const float* aux0(const Unit&) const { return nullptr; }
    __device__ const float* aux1(const Unit&) const { return nullptr; }
};

typedef int i32x8 __attribute__((ext_vector_type(8)));
template <class Epi, class Sched, bool GATHER, bool ALIGN_EPI, bool F8 = false>
__device__ __forceinline__ void gemm_phase(LAS unsigned char* lds, const int K, const Sched& S, const Epi& E, LAS int* rowl = nullptr, LAS float* auxl = nullptr) {
    int tid_ = threadIdx.x; asm volatile("" : "+v"(tid_));
    const int tid = tid_, wid = __builtin_amdgcn_readfirstlane(tid >> 6), lane = tid & 63, wr = wid >> 2, wc = wid & 3, fr = lane & 15, fq = lane >> 4;
    const int nt = K / BK;
    const size_t kstep = (size_t)(BK * 2);
    const unsigned hstep = (unsigned)HALF * (unsigned)K * 2u;
    int Rr[2]; unsigned Cb[2]; unsigned vA[2], vB[2];
#pragma unroll
    for (int i = 0; i < 2; ++i) { int R, C; stage_rc(tid * 16 + i * 8192, R, C); const int Rb = Epi::PERM ? ((R & ~31) + perm32(R & 31)) : R;
        Rr[i] = R; Cb[i] = (unsigned)C * 2u; vA[i] = (unsigned)(R * K + C) * 2u; vB[i] = (unsigned)(Rb * K + C) * 2u; }
    const unsigned ldsw = (unsigned)wid * 1024u;
    const int aoff = lds_byte(wr * 64 + fr, fq * 8), boff = lds_byte(wc * 32 + fr, fq * 8);
#define PG8_SA(b, h) (((b) * 2 + (h)) * HTB)
#define PG8_SB(b, h) ((4 + (b) * 2 + (h)) * HTB)
#define PG8_STG(bufoff, base, o0, o1) do { \
        __builtin_amdgcn_global_load_lds((const unsigned*)((const char*)(base) + (o0)), (LAS unsigned*)(lds + (bufoff) + ldsw), 16, 0, 0); \
        __builtin_amdgcn_global_load_lds((const unsigned*)((const char*)(base) + (o1)), (LAS unsigned*)(lds + (bufoff) + ldsw + 8192), 16, 0, 0); } while (0)
#define PG8_STB(bufoff, base, h) PG8_STG(bufoff, (base) + (h) * (size_t)hstep, vB[0], vB[1])
#define PG8_STA(bufoff, base, h, g0, g1) do { if constexpr (GATHER) { PG8_STG(bufoff, base, g0, g1); } else { PG8_STG(bufoff, (base) + (h) * (size_t)hstep, vA[0], vA[1]); } } while (0)
#define PG8_LD8(p) __builtin_bit_cast(i32x8, __builtin_shufflevector(*(const LAS u32x4*)(p), *(const LAS u32x4*)((p) + 1024), 0, 1, 2, 3, 4, 5, 6, 7))
#define PG8_LDA(dst, b, h) do { _Pragma("unroll") for (int m = 0; m < 4; ++m) { if constexpr (F8) dst##8[m] = PG8_LD8(lds + PG8_SA(b, h) + aoff + m * 2048); else { _Pragma("unroll") for (int k = 0; k < 2; ++k) dst[m][k] = *(const LAS bf16x8*)(lds + PG8_SA(b, h) + aoff + m * 2048 + k * 1024); } } } while (0)
#define PG8_LDB(dst, b, h) do { _Pragma("unroll") for (int n = 0; n < 2; ++n) { if constexpr (F8) dst##8[n] = PG8_LD8(lds + PG8_SB(b, h) + boff + n * 2048); else { _Pragma("unroll") for (int k = 0; k < 2; ++k) dst[n][k] = *(const LAS bf16x8*)(lds + PG8_SB(b, h) + boff + n * 2048 + k * 1024); } } } while (0)
#define PG8_MMA(ai, bj, At, Bt) do { __builtin_amdgcn_s_setprio(1); _Pragma("unroll") for (int m = 0; m < 4; ++m) _Pragma("unroll") for (int n = 0; n < 2; ++n) { \
        if constexpr (F8) asm volatile("v_mfma_f32_16x16x128_f8f6f4 %0, %1, %2, %0" : "+v"(acc[ai][bj][m][n]) : "v"(Bt##8[n]), "v"(At##8[m])); \
        else { _Pragma("unroll") for (int k = 0; k < 2; ++k) acc[ai][bj][m][n] = __builtin_amdgcn_mfma_f32_16x16x32_bf16(Bt[n][k], At[m][k], acc[ai][bj][m][n], 0, 0, 0); } } __builtin_amdgcn_s_setprio(0); } while (0)
#define PG8_WAIT_V(n) asm volatile("s_waitcnt vmcnt(" #n ")" ::: "memory")
#define PG8_WAIT_L(n) asm volatile("s_waitcnt lgkmcnt(" #n ")" ::: "memory")
#define PG8_BAR __builtin_amdgcn_s_barrier()
#define PG8_SCHED __builtin_amdgcn_sched_barrier(0)
#define PG8_GOFF(g, u) do { _Pragma("unroll") for (int h = 0; h < 2; ++h) _Pragma("unroll") for (int i = 0; i < 2; ++i) { \
        if constexpr (GATHER) g[h][i] = (unsigned)(u).rows[h * HALF + Rr[i]] * (unsigned)(K * 2) + Cb[i]; else g[h][i] = 0u; } } while (0)
    Unit cur, nxt; int ui = 0;
    if (!S.next(0, cur)) return;
    f32x4 acc[2][2][4][2];
#pragma unroll
    for (int a = 0; a < 2; ++a)
#pragma unroll
        for (int b = 0; b < 2; ++b)
#pragma unroll
            for (int m = 0; m < 4; ++m)
#pragma unroll
                for (int n = 0; n < 2; ++n) acc[a][b][m][n] = (f32x4){0.f, 0.f, 0.f, 0.f};
    bf16x8 At[4][2], B0[2][2], B1[2][2]; i32x8 At8[4], B08[2], B18[2];
    unsigned gc[2][2], gn[2][2];
    PG8_GOFF(gc, cur);
    const char* cA = cur.A; const char* cB = cur.B;
#define PG8_AUX(u, slot) do { if constexpr (Epi::AUX >= 1) { if (wid < 4) __builtin_amdgcn_global_load_lds((const unsigned*)(S.aux0(u) + wid * 64 + lane), (LAS unsigned*)(auxl + (slot) * 512 + wid * 64), 4, 0, 0); } \
        if constexpr (Epi::AUX >= 2) { if (wid >= 4) __builtin_amdgcn_global_load_lds((const unsigned*)(S.aux1(u) + (wid - 4) * 64 + lane), (LAS unsigned*)(auxl + (slot) * 512 + 256 + (wid - 4) * 64), 4, 0, 0); } } while (0)
    PG8_AUX(cur, 0);
    PG8_STB(PG8_SB(0, 0), cB, 0); PG8_STB(PG8_SB(0, 1), cB, 1); PG8_STA(PG8_SA(0, 0), cA, 0, gc[0][0], gc[0][1]); PG8_STA(PG8_SA(0, 1), cA, 1, gc[1][0], gc[1][1]);
    if (wr == 1) PG8_BAR;
    PG8_WAIT_V(2); PG8_BAR;
    PG8_STB(PG8_SB(1, 0), cB + kstep, 0); PG8_STA(PG8_SA(1, 0), cA + kstep, 0, gc[0][0], gc[0][1]); PG8_STB(PG8_SB(1, 1), cB + kstep, 1);
    PG8_WAIT_V(6); PG8_BAR;
    for (;;) {
        const bool has_next = S.next(ui + 1, nxt);
        const char* nA = has_next ? nxt.A : cA; const char* nB = has_next ? nxt.B : cB;
        if constexpr (GATHER) { if (has_next && wid < 4) __builtin_amdgcn_global_load_lds((const unsigned*)(nxt.rows + wid * 64 + lane), (LAS unsigned*)(rowl + ((ui + 1) & 1) * 256 + wid * 64), 4, 0, 0); }
        if (has_next) PG8_AUX(nxt, (ui + 1) % 3);
#pragma nounroll
        for (int t = 0; t < nt; t += 2) {
            const bool last = (t == nt - 2);
            const char* a1 = cA + (size_t)(t + 1) * kstep;
            const char* a2 = last ? nA : cA + (size_t)(t + 2) * kstep; const char* b2 = last ? nB : cB + (size_t)(t + 2) * kstep;
            const char* a3 = a2 + kstep; const char* b3 = b2 + kstep;
            unsigned o00 = 0u, o01 = 0u, o10 = 0u, o11 = 0u;
            if constexpr (GATHER) {
                if (last && has_next) { const LAS int* rl = rowl + ((ui + 1) & 1) * 256;
#pragma unroll
                    for (int h = 0; h < 2; ++h)
#pragma unroll
                        for (int i = 0; i < 2; ++i) gn[h][i] = (unsigned)rl[h * HALF + Rr[i]] * (unsigned)(K * 2) + Cb[i]; }
                else {
#pragma unroll
                    for (int h = 0; h < 2; ++h)
#pragma unroll
                        for (int i = 0; i < 2; ++i) gn[h][i] = gc[h][i]; }
                o00 = gn[0][0]; o01 = gn[0][1]; o10 = gn[1][0]; o11 = gn[1][1]; }
            PG8_LDB(B0, 0, 0); PG8_LDB(B1, 0, 1); PG8_SCHED; PG8_LDA(At, 0, 0); PG8_STA(PG8_SA(1, 1), a1, 1, gc[1][0], gc[1][1]);
            PG8_WAIT_V(8); PG8_WAIT_L(0); PG8_BAR; PG8_MMA(0, 0, At, B0); PG8_MMA(0, 1, At, B1); PG8_BAR; PG8_SCHED;
            PG8_LDA(At, 0, 1); PG8_STB(PG8_SB(0, 0), b2, 0); PG8_STB(PG8_SB(0, 1), b2, 1); PG8_STA(PG8_SA(0, 0), a2, 0, o00, o01);
            PG8_WAIT_V(8); PG8_WAIT_L(0); PG8_BAR; PG8_MMA(1, 0, At, B0); PG8_MMA(1, 1, At, B1); PG8_BAR; PG8_SCHED;
            PG8_LDB(B0, 1, 0); PG8_LDB(B1, 1, 1); PG8_SCHED; PG8_LDA(At, 1, 0); PG8_STA(PG8_SA(0, 1), a2, 1, o10, o11);
            PG8_WAIT_V(8); PG8_WAIT_L(0); PG8_BAR; PG8_MMA(0, 0, At, B0); PG8_MMA(0, 1, At, B1); PG8_BAR; PG8_SCHED;
            PG8_LDA(At, 1, 1); PG8_STB(PG8_SB(1, 0), b3, 0); PG8_STB(PG8_SB(1, 1), b3, 1); PG8_STA(PG8_SA(1, 0), a3, 0, o00, o01);
            PG8_WAIT_V(8); PG8_WAIT_L(0); PG8_BAR; PG8_MMA(1, 0, At, B0); PG8_MMA(1, 1, At, B1); PG8_BAR; PG8_SCHED;
        }
        if constexpr (ALIGN_EPI) { if (wr == 0) PG8_BAR; }
        if constexpr (F8) asm volatile("s_nop 15\n\ts_nop 15" ::: "memory");
        E(acc, cur, wr, wc, fr, fq, (const LAS float*)(auxl + (ui % 3) * 512));
#if defined(EPI_REP)
        if (Epi::PROBE_ID == EPI_REP) E(acc, cur, wr, wc, fr, fq, (const LAS float*)(auxl + (ui % 3) * 512));
#endif
        if (!has_next) break;
#pragma unroll
        for (int a = 0; a < 2; ++a)
#pragma unroll
            for (int b = 0; b < 2; ++b)
#pragma unroll
                for (int m = 0; m < 4; ++m)
#pragma unroll
                    for (int n = 0; n < 2; ++n) acc[a][b][m][n] = (f32x4){0.f, 0.f, 0.f, 0.f};
        cur = nxt; cA = nA; cB = nB; ++ui;
#pragma unroll
        for (int h = 0; h < 2; ++h)
#pragma unroll
            for (int i = 0; i < 2; ++i) gc[h][i] = gn[h][i];
        if constexpr (ALIGN_EPI) { if (wr == 1) PG8_BAR; }
    }
    PG8_WAIT_V(0);
    if constexpr (!ALIGN_EPI) { if (wr == 0) PG8_BAR; }
    PG8_BAR;
#undef PG8_SA
#undef PG8_SB
#undef PG8_STG
#undef PG8_STB
#undef PG8_STA
#undef PG8_LDA
#undef PG8_LDB
#undef PG8_MMA
#undef PG8_LD8
#undef PG8_WAIT_V
#undef PG8_WAIT_L
#undef PG8_BAR
#undef PG8_SCHED
#undef PG8_GOFF
#undef PG8_AUX
}
}
using pg8::Unit;

struct EpiInProj {
    static constexpr bool PERM = true; static constexpr int PROBE_ID = 1, AUX = 0;
    bf16_t* qkv; const float* qg; const float* kg; const float* cosT; const float* sinT;
    __device__ __forceinline__ void operator()(const f32x4 (&acc)[2][2][4][2], const Unit& u, int wr, int wc, int fr, int fq, const LAS float* aux) const {
        const int row0 = u.pm * 256 + wr * 64 + fr;
        const int t = u.pn >> 1;
        bf16_t* base = qkv + (size_t)t * ((size_t)MTOK * 512);
        if (t < 2) {
            const float* g = (t == 0) ? qg : kg; const float sc = (t == 0) ? C2 : 1.0f;
            f32x4 glo[2], ghi[2];
#pragma unroll
            for (int n = 0; n < 2; ++n) { glo[n] = *(const f32x4*)(g + 8 * fq + 4 * n); ghi[n] = *(const f32x4*)(g + 32 + 8 * fq + 4 * n); }
            const int hh = (u.pn & 1) * 4 + wc;
            f32x4 csb[2][2], snb[2][2];
#pragma unroll
            for (int n = 0; n < 2; ++n) { const int pos0 = row0 & (SEQ - 1); csb[0][n] = *(const f32x4*)(cosT + pos0 * 32 + 8 * fq + 4 * n); snb[0][n] = *(const f32x4*)(sinT + pos0 * 32 + 8 * fq + 4 * n); }
#pragma unroll
            for (int ai = 0; ai < 2; ++ai)
#pragma unroll
                for (int m = 0; m < 4; ++m) {
                    const int row = row0 + ai * 128 + m * 16; const int gi = ai * 4 + m;
                    if (gi < 7) { const int rown = row0 + ((gi + 1) >> 2) * 128 + ((gi + 1) & 3) * 16, posn = rown & (SEQ - 1);
#pragma unroll
                        for (int n = 0; n < 2; ++n) { csb[(gi + 1) & 1][n] = *(const f32x4*)(cosT + posn * 32 + 8 * fq + 4 * n); snb[(gi + 1) & 1][n] = *(const f32x4*)(sinT + posn * 32 + 8 * fq + 4 * n); } }
                    float ss = 0.f;
#pragma unroll
                    for (int bj = 0; bj < 2; ++bj)
#pragma unroll
                        for (int n = 0; n < 2; ++n) { const f32x4 v = acc[ai][bj][m][n]; ss += (v[0] * v[0] + v[1] * v[1]) + (v[2] * v[2] + v[3] * v[3]); }
                    ss += __shfl_xor(ss, 16); ss += __shfl_xor(ss, 32);
                    const float rs = 1.0f / sqrtf(ss * (1.0f / 64.0f) + 1e-6f);
                    u32x4 wlo, whi;
#pragma unroll
                    for (int n = 0; n < 2; ++n) {
                        const f32x4 cs = csb[gi & 1][n], sn = snb[gi & 1][n];
                        const f32x4 x1 = acc[ai][0][m][n] * rs * glo[n], x2 = acc[ai][1][m][n] * rs * ghi[n];
                        const f32x4 o1 = (x1 * cs - x2 * sn) * sc, o2 = (x2 * cs + x1 * sn) * sc;
                        wlo[2 * n] = cvt_pk_bf16(o1[0], o1[1]); wlo[2 * n + 1] = cvt_pk_bf16(o1[2], o1[3]);
                        whi[2 * n] = cvt_pk_bf16(o2[0], o2[1]); whi[2 * n + 1] = cvt_pk_bf16(o2[2], o2[3]);
                    }
                    if (t == 0) { bf16_t* p = base + (size_t)row * 512 + hh * 64 + 8 * fq; *(u32x4*)p = wlo; *(u32x4*)(p + 32) = whi; }
                    else {
                        bf16_t* p = base + ((((size_t)(row >> 6) * 8 + hh) * 8 + fq) * 64 + (row & 63)) * 8; *(u32x4*)p = wlo; *(u32x4*)(p + 4 * 512) = whi; }
                }
        } else {
            const int col0 = (u.pn & 1) * 256 + wc * 32 + 8 * fq;
#pragma unroll
            for (int ai = 0; ai < 2; ++ai)
#pragma unroll
                for (int m = 0; m < 4; ++m) { const int row = row0 + ai * 128 + m * 16;
                    bf16_t* rowp = (t == 2) ? base + (((size_t)(row >> 6) * 4 + (col0 >> 7)) * 64 + (row & 63)) * 128 + (col0 & 127) : base + (size_t)row * 512 + col0;
#pragma unroll
                    for (int bj = 0; bj < 2; ++bj) { const f32x4 v0 = acc[ai][bj][m][0], v1 = acc[ai][bj][m][1]; u32x4 w;
                        w.x = cvt_pk_bf16(v0[0], v0[1]); w.y = cvt_pk_bf16(v0[2], v0[3]); w.z = cvt_pk_bf16(v1[0], v1[1]); w.w = cvt_pk_bf16(v1[2], v1[3]);
                        *(u32x4*)(rowp + bj * ((t == 2) ? 64 * 128 : 128)) = w; } }
        }
    }
};
struct EpiOutProj {
    static constexpr bool PERM = true; static constexpr int PROBE_ID = 2, AUX = 0;
    const float* x; bf16_t* x1b; const float* modv; float* ssq;
    __device__ __forceinline__ void operator()(const f32x4 (&acc)[2][2][4][2], const Unit& u, int wr, int wc, int fr, int fq, const LAS float* aux) const {
        const int row0 = u.pm * 256 + wr * 64 + fr, b = u.pm >> 5, col0 = u.pn * 256 + wc * 32 + 8 * fq;
        const float* g1 = modv + (size_t)b * 6144 + 2048;
        f32x4 gv[2][2];
#pragma unroll
        for (int bj = 0; bj < 2; ++bj)
#pragma unroll
            for (int n = 0; n < 2; ++n) gv[bj][n] = *(const f32x4*)(g1 + col0 + bj * 128 + n * 4);
        f32x4 xb[4][2][2];
#pragma unroll
        for (int g = 0; g < 4; ++g)
#pragma unroll
            for (int bj = 0; bj < 2; ++bj)
#pragma unroll
                for (int n = 0; n < 2; ++n) xb[g][bj][n] = __builtin_nontemporal_load((const f32x4*)(x + (size_t)(row0 + g * 16) * DM + col0 + bj * 128 + n * 4));
#pragma unroll
        for (int ai = 0; ai < 2; ++ai)
#pragma unroll
            for (int m = 0; m < 4; ++m) { const int row = row0 + ai * 128 + m * 16; const size_t ro = (size_t)row * DM + col0; float sq = 0.f; const int gi = ai * 4 + m;
#pragma unroll
                for (int bj = 0; bj < 2; ++bj) { f32x4 o[2];
#pragma unroll
                    for (int n = 0; n < 2; ++n) { const f32x4 xv = xb[gi & 3][bj][n]; o[n] = xv + gv[bj][n] * acc[ai][bj][m][n];
                        sq += (o[n][0] * o[n][0] + o[n][1] * o[n][1]) + (o[n][2] * o[n][2] + o[n][3] * o[n][3]); }
                    u32x4 w; w.x = cvt_pk_bf16(o[0][0], o[0][1]); w.y = cvt_pk_bf16(o[0][2], o[0][3]); w.z = cvt_pk_bf16(o[1][0], o[1][1]); w.w = cvt_pk_bf16(o[1][2], o[1][3]);
                    *(u32x4*)(x1b + ro + bj * 128) = w; }
                sq += __shfl_xor(sq, 16); sq += __shfl_xor(sq, 32);
                if (fq == 0) ssq[(size_t)row * 16 + u.pn * 4 + wc] = sq;
                if (gi < 4) { const size_t rn = (size_t)(row0 + 128 + gi * 16) * DM + col0;
#pragma unroll
                    for (int bj = 0; bj < 2; ++bj)
#pragma unroll
                        for (int n = 0; n < 2; ++n) xb[gi][bj][n] = __builtin_nontemporal_load((const f32x4*)(x + rn + bj * 128 + n * 4)); } }
    }
};
__device__ __forceinline__ u32x2 pack_fp8x8(const float (&o)[8]) { int w0 = 0, w1 = 0;
    w0 = __builtin_amdgcn_cvt_pk_fp8_f32(o[0], o[1], w0, false); w0 = __builtin_amdgcn_cvt_pk_fp8_f32(o[2], o[3], w0, true);
    w1 = __builtin_amdgcn_cvt_pk_fp8_f32(o[4], o[5], w1, false); w1 = __builtin_amdgcn_cvt_pk_fp8_f32(o[6], o[7], w1, true); u32x2 r; r.x = (unsigned)w0; r.y = (unsigned)w1; return r; }
__device__ __forceinline__ u32x4 pair16(u32x2 p, u32x2 q) {
    const auto rx = __builtin_amdgcn_permlane16_swap(p.x, q.x, false, false); const auto ry = __builtin_amdgcn_permlane16_swap(p.y, q.y, false, false);
    return (u32x4){rx[0], ry[0], rx[1], ry[1]}; }
constexpr float WSCALE = 64.0f, WINV = 1.0f / 64.0f;
struct EpiMoe1 {
    static constexpr bool PERM = true; static constexpr int PROBE_ID = 3, AUX = 2;
    unsigned char* act; const float* b1;
    __device__ __forceinline__ void operator()(const f32x4 (&acc)[2][2][4][2], const Unit& u, int wr, int wc, int fr, int fq, const LAS float* aux) const {
        const int row0 = u.pm * 256 + wr * 64 + fr, col0 = u.pn * 128 + wc * 32 + 8 * fq;
        f32x4 bg[2], bl[2];
#pragma unroll
        for (int n = 0; n < 2; ++n) { bg[n] = *(const LAS f32x4*)(aux + wc * 32 + 8 * fq + 4 * n); bl[n] = *(const LAS f32x4*)(aux + 256 + wc * 32 + 8 * fq + 4 * n) + 1.0f; }
#pragma unroll
        for (int ai = 0; ai < 2; ++ai)
#pragma unroll
            for (int mp = 0; mp < 2; ++mp) { u32x2 pk[2];
#pragma unroll
              for (int mi = 0; mi < 2; ++mi) { const int m = 2 * mp + mi;
                float o[8];
#pragma unroll
                for (int n = 0; n < 2; ++n)
#pragma unroll
                    for (int p = 0; p < 2; ++p) {
                        const f32x2 a0 = {acc[ai][0][m][n][2 * p], acc[ai][0][m][n][2 * p + 1]}, a1 = {acc[ai][1][m][n][2 * p], acc[ai][1][m][n][2 * p + 1]};
                        const f32x2 bgp = {bg[n][2 * p], bg[n][2 * p + 1]}, blp = {bl[n][2 * p], bl[n][2 * p + 1]};
                        f32x2 g = a0 * WINV + bgp; g.x = fminf(g.x, 7.0f); g.y = fminf(g.y, 7.0f);
                        const f32x2 z = g * (-2.4554669596f);
                        f32x2 e; e.x = __builtin_amdgcn_exp2f(z.x); e.y = __builtin_amdgcn_exp2f(z.y);
                        const f32x2 d = e + 1.0f;
                        f32x2 r; r.x = __builtin_amdgcn_rcpf(d.x); r.y = __builtin_amdgcn_rcpf(d.y);
                        f32x2 l = a1 * WINV + blp; l.x = __builtin_amdgcn_fmed3f(l.x, -6.0f, 8.0f); l.y = __builtin_amdgcn_fmed3f(l.y, -6.0f, 8.0f);
                        const f32x2 v = (g * r) * l;
                        o[4 * n + 2 * p] = v.x; o[4 * n + 2 * p + 1] = v.y;
                    }
                pk[mi] = pack_fp8x8(o); }
              *(u32x4*)(act + (size_t)(row0 + ai * 128 + (2 * mp + (fq & 1)) * 16) * 1024 + col0 - 8 * (fq & 1)) = pair16(pk[0], pk[1]);
            }
    }
};
constexpr float YSCALE = 16.0f, YINV = 1.0f / 16.0f;
struct EpiMoe2 {
    static constexpr bool PERM = true; static constexpr int PROBE_ID = 4, AUX = 2;
    unsigned char* y; const float* b2; const float* rowg;
    __device__ __forceinline__ void operator()(const f32x4 (&acc)[2][2][4][2], const Unit& u, int wr, int wc, int fr, int fq, const LAS float* aux) const {
        const int row0 = u.pm * 256 + wr * 64 + fr, col0 = u.pn * 256 + wc * 32 + 8 * fq;
        f32x4 bv[2][2];
#pragma unroll
        for (int bj = 0; bj < 2; ++bj)
#pragma unroll
            for (int n = 0; n < 2; ++n) bv[bj][n] = *(const LAS f32x4*)(aux + bj * 128 + wc * 32 + 8 * fq + 4 * n);
#pragma unroll
        for (int ai = 0; ai < 2; ++ai)
#pragma unroll
            for (int mp = 0; mp < 2; ++mp) { u32x2 pk[2][2];
#pragma unroll
                for (int mi = 0; mi < 2; ++mi) { const int m = 2 * mp + mi; const float gt = aux[256 + ai * 128 + wr * 64 + m * 16 + fr] * YSCALE, gw = gt * WINV;
#pragma unroll
                    for (int bj = 0; bj < 2; ++bj) { const f32x4 v0 = acc[ai][bj][m][0] * gw + bv[bj][0] * gt, v1 = acc[ai][bj][m][1] * gw + bv[bj][1] * gt;
                        const float o[8] = {v0[0], v0[1], v0[2], v0[3], v1[0], v1[1], v1[2], v1[3]}; pk[mi][bj] = pack_fp8x8(o); } }
                unsigned char* rowp = y + (size_t)(row0 + ai * 128 + (2 * mp + (fq & 1)) * 16) * 1024 + col0 - 8 * (fq & 1);
#pragma unroll
                for (int bj = 0; bj < 2; ++bj) *(u32x4*)(rowp + bj * 128) = pair16(pk[0][bj], pk[1][bj]); }
    }
};
struct MoeOrder {
    int c, lg, per, ntiles; const LAS int* tile_e; const int* rowtok; const char* Ab; size_t a_tstep; const char* Bt; size_t estride, b_tstep; const float* bias; int bias_e, bias_pn; const float* rowg;
    __device__ bool next(int i, Unit& u) const {
        const int w = c >> 3, mt = (c & 7) + 8 * (per * i + (w >> lg)), pn = w & ((1 << lg) - 1); if (mt >= ntiles) return false;
        const int e = __builtin_amdgcn_readfirstlane(tile_e[mt]);
        u.pm = mt; u.pn = pn; u.e = e; u.A = Ab + (size_t)mt * a_tstep; u.B = Bt + (size_t)e * estride + (size_t)pn * b_tstep; u.rows = rowtok + 256 * mt; return true;
    }
    __device__ const float* aux0(const Unit& u) const { return bias + (size_t)u.e * bias_e + u.pn * bias_pn; }
    __device__ const float* aux1(const Unit& u) const { return rowg ? rowg + 256 * u.pm : bias + (size_t)u.e * bias_e + u.pn * bias_pn + 1024; }
};

#define XB_TMO      128
#define XB_XCNT(j)  (256  + 64 * (j))
#define XB_XSUB(j)  (1280 + 64 * (j))
#define XB_XGEN(j)  (2304 + 64 * (j))
#define XB_TOP      3328
#define XB_TOPGEN   3392
#define XCD_BAR_WORDS 3456
#define XB_SPIN_CAP (1u << 21)
__device__ __forceinline__ unsigned xb_ld(unsigned* p)              { return __hip_atomic_load(p, __ATOMIC_RELAXED, __HIP_MEMORY_SCOPE_AGENT); }
__device__ __forceinline__ unsigned xb_add(unsigned* p, unsigned v) { return __hip_atomic_fetch_add(p, v, __ATOMIC_RELAXED, __HIP_MEMORY_SCOPE_AGENT); }
__device__ __forceinline__ unsigned xb_xcc_id() { return (unsigned)__builtin_amdgcn_s_getreg((3 << 11) | 20) & 0xFu; }
#define XB_SPIN(cond, bar) do { unsigned _sp = 0; while (cond) { __builtin_amdgcn_s_sleep(1); \
    if ((++_sp & 255u) == 0u) { if (xb_ld(&(bar)[XB_TMO])) break; if (_sp > XB_SPIN_CAP) { atomicAdd(&(bar)[XB_TMO], 1u); break; } } } } while (0)
struct XcdBarrier { unsigned* bar; unsigned x; volatile LAS unsigned* st; };
__device__ __forceinline__ XcdBarrier xcd_barrier_post(unsigned* bar, volatile LAS unsigned* st) {
    XcdBarrier b; b.bar = bar; b.x = xb_xcc_id(); b.st = st;
    if (threadIdx.x == 0) (void)xb_add(&bar[XB_XCNT(b.x)], 1u);
    return b;
}
__device__ __forceinline__ void xcd_barrier_complete(unsigned* bar, unsigned x, unsigned& nloc, unsigned& nx) {
    const unsigned G = gridDim.x * gridDim.y * gridDim.z;
    unsigned sum, cnt, mine, sp = 0u;
    for (;;) {
        sum = 0u; cnt = 0u; mine = 0u;
#pragma unroll
        for (unsigned j = 0; j < 16; ++j) { const unsigned c = xb_ld(&bar[XB_XCNT(j)]); sum += c; cnt += (c > 0u) ? 1u : 0u; mine = (j == x) ? c : mine; }
        if (sum == G) break;
        __builtin_amdgcn_s_sleep(1);
        if ((++sp & 255u) == 0u) { if (xb_ld(&bar[XB_TMO])) break; if (sp > XB_SPIN_CAP) { atomicAdd(&bar[XB_TMO], 1u); break; } }
    }
    nloc = mine > 0u ? mine : 1u; nx = cnt > 0u ? cnt : 1u;
}
__device__ __forceinline__ void xcd_barrier(const XcdBarrier& b) {
    asm volatile("s_waitcnt vmcnt(0)" ::: "memory");
    __syncthreads();
    if (threadIdx.x == 0) {
        unsigned* bar = b.bar;
        __builtin_amdgcn_s_waitcnt(0);
        unsigned nloc = b.st[0], nx = b.st[1];
        if (nloc == 0u) { xcd_barrier_complete(bar, b.x, nloc, nx); b.st[0] = nloc; b.st[1] = nx; }
        const unsigned old = xb_add(&bar[XB_XSUB(b.x)], 1u);
        const unsigned gen = old / nloc;
        if (old + 1u == (gen + 1u) * nloc) {
            __builtin_amdgcn_fence(__ATOMIC_RELEASE, "agent");
            asm volatile("s_waitcnt vmcnt(0)" ::: "memory");
            const unsigned og = xb_add(&bar[XB_TOP], 1u);
            const unsigned tg = og / nx;
            if (og + 1u == (tg + 1u) * nx) xb_add(&bar[XB_TOPGEN], 1u);
            else XB_SPIN(xb_ld(&bar[XB_TOPGEN]) == tg, bar);
            __builtin_amdgcn_fence(__ATOMIC_ACQUIRE, "agent");
            xb_add(&bar[XB_XGEN(b.x)], 1u);
            asm volatile("s_waitcnt vmcnt(0)" ::: "memory");
        } else {
            XB_SPIN(xb_ld(&bar[XB_XGEN(b.x)]) == gen, bar);
            __builtin_amdgcn_fence(__ATOMIC_ACQUIRE, "agent");
            asm volatile("s_waitcnt vmcnt(0)" ::: "memory");
        }
    }
    __syncthreads();
}

struct Args { const float* in[28]; float* out; unsigned char* ws; int ph_lo, ph_hi; };
enum { I_X = 0, I_C, I_WADA, I_BADA, I_N1G, I_WIN, I_QG, I_KG, I_LQ1, I_LK1, I_LQ2, I_LK2, I_SUBG, I_CONVW, I_CONVB, I_WRGA, I_BRGA, I_WRGX, I_BRGX, I_LRUL, I_WOUT, I_N2G, I_WR, I_BR, I_W1, I_B1, I_W2, I_B2 };

__device__ __forceinline__ int map_row(int mode, int s) {
    if (mode == 1) { const int pn = s >> 8; if (pn < 4) { const int wc = (s & 255) >> 6, dim = s & 63; return (pn << 8) + ((dim >> 5) << 7) + (wc << 5) + (dim & 31); } return s; }
    if (mode == 2) { const int lin = s >> 10, s2 = s & 1023; return ((s2 >> 7) << 8) + (lin << 7) + (s2 & 127); }
    return s;
}
__device__ __forceinline__ void transpose_item(const float* W, int K, int N, bf16_t* WT, int mode, LAS float* scr, int item, int lane) {
    const int nblk = N / 32, kb = item / nblk, nb = item % nblk, k0 = 64 * kb, n0 = 32 * nb;
    { float wv[32];
#pragma unroll
      for (int i = 0; i < 32; ++i) wv[i] = __builtin_nontemporal_load(W + (size_t)(k0 + 2 * i + (lane >> 5)) * N + n0 + (lane & 31));
#pragma unroll
      for (int i = 0; i < 32; ++i) scr[(2 * i + (lane >> 5)) * 33 + (lane & 31)] = wv[i]; }
    LDS_WAIT(); asm volatile("" ::: "memory");
    const int c = lane & 7;
#pragma unroll
    for (int j = 0; j < 4; ++j) { const int n = (lane >> 3) + 8 * j; const LAS float* s = scr + (8 * c) * 33 + n;
        u32x4 o; o.x = cvt_pk_bf16(s[0 * 33], s[1 * 33]); o.y = cvt_pk_bf16(s[2 * 33], s[3 * 33]); o.z = cvt_pk_bf16(s[4 * 33], s[5 * 33]); o.w = cvt_pk_bf16(s[6 * 33], s[7 * 33]);
        *(u32x4*)(WT + (size_t)map_row(mode, n0 + n) * K + k0 + 8 * c) = o; }
    LDS_WAIT(); asm volatile("" ::: "memory");
}
__device__ __forceinline__ void transpose_item_f8(const float* W, int K, int N, unsigned char* WT, int mode, LAS float* scr, int item, int lane) {
    const int nblk = N / 32, kb = item / nblk, nb = item % nblk, k0 = 64 * kb, n0 = 32 * nb;
    { float wv[32];
#pragma unroll
      for (int i = 0; i < 32; ++i) wv[i] = __builtin_nontemporal_load(W + (size_t)(k0 + 2 * i + (lane >> 5)) * N + n0 + (lane & 31));
#pragma unroll
      for (int i = 0; i < 32; ++i) scr[(2 * i + (lane >> 5)) * 33 + (lane & 31)] = wv[i]; }
    LDS_WAIT(); asm volatile("" ::: "memory");
    const int c = lane & 7;
#pragma unroll
    for (int j = 0; j < 4; ++j) { const int n = (lane >> 3) + 8 * j; const LAS float* sp = scr + (8 * c) * 33 + n;
        const float o[8] = {sp[0 * 33] * WSCALE, sp[1 * 33] * WSCALE, sp[2 * 33] * WSCALE, sp[3 * 33] * WSCALE, sp[4 * 33] * WSCALE, sp[5 * 33] * WSCALE, sp[6 * 33] * WSCALE, sp[7 * 33] * WSCALE};
        *(u32x2*)(WT + (size_t)map_row(mode, n0 + n) * K + k0 + 8 * c) = pack_fp8x8(o); }
    LDS_WAIT(); asm volatile("" ::: "memory");
}
__device__ __forceinline__ double sin_poly(double x) { const double x2 = x * x; double p = -1.0 / 51090942171709440000.0;
    p = p * x2 + 1.0 / 121645100408832000.0; p = p * x2 - 1.0 / 355687428096000.0; p = p * x2 + 1.0 / 1307674368000.0; p = p * x2 - 1.0 / 6227020800.0; p = p * x2 + 1.0 / 39916800.0;
    p = p * x2 - 1.0 / 362880.0; p = p * x2 + 1.0 / 5040.0; p = p * x2 - 1.0 / 120.0; p = p * x2 + 1.0 / 6.0; p = p * x2 - 1.0; return -p * x; }
__device__ __forceinline__ double cos_poly(double x) { const double x2 = x * x; double p = -1.0 / 1124000727777607680000.0;
    p = p * x2 + 1.0 / 2432902008176640000.0; p = p * x2 - 1.0 / 6402373705728000.0; p = p * x2 + 1.0 / 20922789888000.0; p = p * x2 - 1.0 / 87178291200.0; p = p * x2 + 1.0 / 479001600.0;
    p = p * x2 - 1.0 / 3628800.0; p = p * x2 + 1.0 / 40320.0; p = p * x2 - 1.0 / 720.0; p = p * x2 + 1.0 / 24.0; p = p * x2 - 0.5; p = p * x2 + 1.0; return p; }

__device__ __forceinline__ void phase_mod(const Args& a, LAS unsigned char* lds, int bid, int G, int tid, int lane, int wave) {
    unsigned char* ws = a.ws;
    LAS float* sl = (LAS float*)(lds + 65536);
    const int gw = bid * NWAVES + wave;
    if (bid * NWAVES < 768) {
        const float* c = a.in[I_C];
        for (int i = tid; i < NB * DM; i += 512) { const float v = c[i]; sl[i] = v / (1.0f + __expf(-v)); }
        __syncthreads();
        if (gw < 768) {
            const int cg = gw >> 3, ks = gw & 7;
            const int n = cg * 64 + lane; const float* w = a.in[I_WADA] + (size_t)(ks * 128) * 6144 + n;
            float acc[8];
#pragma unroll
            for (int b = 0; b < 8; ++b) acc[b] = 0.f;
            for (int k0 = 0; k0 < 128; k0 += 16) {
                float wv[16];
#pragma unroll
                for (int j = 0; j < 16; ++j) wv[j] = w[(size_t)(k0 + j) * 6144];
#pragma unroll
                for (int j = 0; j < 16; ++j)
#pragma unroll
                    for (int b = 0; b < 8; ++b) acc[b] += sl[b * DM + ks * 128 + k0 + j] * wv[j];
            }
            float* mp = (float*)(ws + WS_MODP);
#pragma unroll
            for (int b = 0; b < 8; ++b) mp[(size_t)(ks * 8 + b) * 6144 + n] = acc[b];
        }
        __syncthreads();
    }
}
__device__ __forceinline__ void phase_misc(const Args& a, LAS unsigned char* lds, int bid, int G, int tid, int lane, int wave) {
    unsigned char* ws = a.ws;
    { float* cosT = (float*)(ws + WS_ROPE); float* sinT = cosT + SEQ * 32;
      for (int idx = bid * 512 + tid; idx < SEQ * 32; idx += G * 512) { const int pos = idx >> 5, i = idx & 31;
          const float inv = exp2f(-(float)i * (13.287712379549449f / 32.0f)); const float ang = (float)pos * inv;
          double r = (double)ang * 0.15915494309189535; r -= rint(r); const double xr = r * 6.283185307179586;
          cosT[idx] = (float)cos_poly(xr); sinT[idx] = (float)sin_poly(xr); } }
    if (bid == 96 && wave == 0) {
        const float s1 = wave_sum(a.in[I_LQ1][lane] * a.in[I_LK1][lane]), s2 = wave_sum(a.in[I_LQ2][lane] * a.in[I_LK2][lane]);
        const float gq = wave_max(fabsf(a.in[I_QG][lane])), gk = wave_max(fabsf(a.in[I_KG][lane]));
        float* sc = (float*)(ws + WS_SCAL);
        if (lane == 0) { sc[0] = expf(s1) - expf(s2) + 0.2f; sc[1] = 8.0f * gq * gk * 1.4426950408889634f * 1.01f + 0.05f; }
    }
    if (bid == 97) { float* cd = (float*)(ws + WS_SCAL + 4096); const float xl = -a.in[I_LRUL][tid]; cd[tid] = 8.0f * (fmaxf(xl, 0.f) + log1pf(expf(-fabsf(xl)))); }
    { bf16_t* wg = (bf16_t*)(ws + WS_WGT);
      for (int idx = bid * 512 + tid; idx < 8 * 2 * 64 * 64; idx += G * 512) { const int cc = idx & 63, d = (idx >> 6) & 63, g = (idx >> 12) & 1, n = idx >> 13;
          const float v = (g == 0 ? a.in[I_WRGA] : a.in[I_WRGX])[(size_t)(n * 64 + cc) * 64 + d]; wg[idx] = (bf16_t)(cvt_pk_bf16(v, 0.f) & 0xffffu); } }
    { bf16_t* wf = (bf16_t*)(ws + WS_WRF);
      for (int idx = bid * 512 + tid; idx < 64 * 64 * 8; idx += G * 512) { const int sI = idx & 7, ln = (idx >> 3) & 63, ks = idx >> 9; const float w = a.in[I_WR][(size_t)(16 * ks + 8 * (ln >> 5) + sI) * 32 + (ln & 31)];
          const unsigned hb = cvt_pk_bf16(w, 0.f) & 0xffffu; const float lo = w - __uint_as_float(hb << 16); wf[idx] = (bf16_t)hb; wf[32768 + idx] = (bf16_t)(cvt_pk_bf16(lo, 0.f) & 0xffffu); } }
    LAS float* scr = (LAS float*)(lds + 16384 + wave * 8704);
    const int gw = bid * NWAVES + wave, NGW = G * NWAVES;
    constexpr int I_IN = 16 * (INW / 32), I_OUT = 16 * 32;
    for (int it = gw; it < I_IN + I_OUT; it += NGW) {
        if (it < I_IN) transpose_item(a.in[I_WIN], DM, INW, (bf16_t*)(ws + WS_WIN), 1, scr, it, lane);
        else transpose_item(a.in[I_WOUT], DM, DM, (bf16_t*)(ws + WS_WOUT), 0, scr, it - I_IN, lane);
    }
}
__device__ __forceinline__ void convert_expert_weights(const Args& a, LAS unsigned char* lds, int bid, int G, int lane, int wave) {
    unsigned char* ws = a.ws;
    LAS float* scr = (LAS float*)(lds + 16384 + wave * 8704);
    const int gw = bid * NWAVES + wave, NGW = G * NWAVES;
    constexpr int I_M1E = 16 * 64, I_M2E = 16 * 32;
    for (int it = gw; it < NEXP * (I_M1E + I_M2E); it += NGW) {
        if (it < NEXP * I_M1E) { const int e = it / I_M1E; transpose_item_f8(a.in[I_W1] + (size_t)e * DM * 2048, DM, 2048, (unsigned char*)(ws + WS_W1) + (size_t)e * 2048 * DM, 2, scr, it % I_M1E, lane); }
        else { const int r = it - NEXP * I_M1E, e = r / I_M2E; transpose_item_f8(a.in[I_W2] + (size_t)e * DFF * DM, DFF, DM, (unsigned char*)(ws + WS_W2) + (size_t)e * DM * DFF, 0, scr, r % I_M2E, lane); }
    }
}

__device__ __forceinline__ void phase_hn(const Args& a, LAS unsigned char* lds, int bid, int G, int tid, int lane, int wave) {
    unsigned char* ws = a.ws;
    LAS float* A1 = (LAS float*)lds; LAS float* SH = A1 + DM;
    const float* mp = (const float*)(ws + WS_MODP); const float* bada = a.in[I_BADA]; float* modv = (float*)(ws + WS_MODV);
    for (int tile = bid; tile < MTOK / 256; tile += G) {
        const int b = tile >> 5;
        for (int col = tid; col < DM; col += 512) {
            float sh = bada[col], sc = bada[DM + col];
#pragma unroll
            for (int ks = 0; ks < 8; ++ks) { sh += mp[(size_t)(ks * 8 + b) * 6144 + col]; sc += mp[(size_t)(ks * 8 + b) * 6144 + DM + col]; }
            A1[col] = a.in[I_N1G][col] * (1.0f + sc); SH[col] = sh;
        }
        if ((tile & 31) == 0) for (int n = tid; n < 6144; n += 512) { float v = bada[n];
#pragma unroll
            for (int ks = 0; ks < 8; ++ks) v += mp[(size_t)(ks * 8 + b) * 6144 + n];
            modv[(size_t)b * 6144 + n] = v; }
        __syncthreads();
        f32x4 av[4], sv[4];
#pragma unroll
        for (int j = 0; j < 4; ++j) { av[j] = *(const LAS f32x4*)(A1 + 4 * lane + 256 * j); sv[j] = *(const LAS f32x4*)(SH + 4 * lane + 256 * j); }
        for (int r = 0; r < 32; r += 2) {
            const size_t row = (size_t)tile * 256 + wave * 32 + r;
            const f32x4* xr = (const f32x4*)(a.in[I_X] + row * DM) + lane;
            f32x4 v[2][4]; float sq[2] = {0.f, 0.f};
#pragma unroll
            for (int q = 0; q < 2; ++q)
#pragma unroll
                for (int j = 0; j < 4; ++j) v[q][j] = __builtin_nontemporal_load(xr + q * (DM / 4) + 64 * j);
#pragma unroll
            for (int q = 0; q < 2; ++q)
#pragma unroll
                for (int j = 0; j < 4; ++j) sq[q] += (v[q][j][0] * v[q][j][0] + v[q][j][1] * v[q][j][1]) + (v[q][j][2] * v[q][j][2] + v[q][j][3] * v[q][j][3]);
#pragma unroll
            for (int q = 0; q < 2; ++q) {
                const float rstd = 1.0f / sqrtf(wave_sum(sq[q]) * (1.0f / DM) + 1e-6f);
                u32x2* o8 = (u32x2*)((bf16_t*)(ws + WS_XN) + (row + q) * DM) + lane;
#pragma unroll
                for (int j = 0; j < 4; ++j) { const f32x4 y = v[q][j] * rstd * av[j] + sv[j]; u32x2 w; w.x = cvt_pk_bf16(y[0], y[1]); w.y = cvt_pk_bf16(y[2], y[3]); o8[64 * j] = w; }
            }
        }
        __syncthreads();
    }
}

constexpr int LRU_WAVE_LDS = 12544;
template <bool FINAL>
__device__ __forceinline__ void lru_wave(const Args& a, unsigned char* ws, LAS unsigned char* wl, int b, int n, int c0, int nch, int lane) {
    LAS bf16_t* XCB = (LAS bf16_t*)wl;
    LAS float* AA = (LAS float*)(wl + 2304);
    LAS float* UU = AA + 1024;
    LAS float* CW = UU + 1024;
    const int fr = lane & 15, fq = lane >> 4, cg = lane & 7, rp = lane >> 3, chn = n * 64 + lane;
#pragma unroll
    for (int j = 0; j < 4; ++j) CW[j * 64 + lane] = a.in[I_CONVW][j * 512 + chn];
    CW[256 + lane] = a.in[I_CONVB][chn]; CW[320 + lane] = a.in[I_BRGA][chn]; CW[384 + lane] = a.in[I_BRGX][chn]; CW[448 + lane] = ((const float*)(ws + WS_SCAL + 4096))[chn] * 1.4426950408889634f;
    bf16x8 wa[4][2], wx[4][2];
    { const bf16_t* wg = (const bf16_t*)(ws + WS_WGT) + (size_t)n * 2 * 4096;
#pragma unroll
      for (int cb = 0; cb < 4; ++cb)
#pragma unroll
          for (int ks = 0; ks < 2; ++ks) { wa[cb][ks] = *(const bf16x8*)(wg + (size_t)(16 * cb + fr) * 64 + 32 * ks + 8 * fq); wx[cb][ks] = *(const bf16x8*)(wg + 4096 + (size_t)(16 * cb + fr) * 64 + 32 * ks + 8 * fq); } }
    const bf16_t* XR = (const bf16_t*)(ws + WS_Q) + (size_t)3 * MTOK * 512 + (size_t)b * SEQ * 512 + n * 64 + cg * 8;
    const bf16_t* GR = (const bf16_t*)(ws + WS_Q) + (size_t)4 * MTOK * 512 + (size_t)b * SEQ * 512 + n * 64 + cg * 8;
    bf16_t* MIXp = (bf16_t*)(ws + WS_MIX) + (size_t)b * SEQ * DM + 512 + n * 64 + cg * 8;
    bf16_t* HLp = (bf16_t*)(ws + WS_HL) + (size_t)b * SEQ * 512 + n * 64 + cg * 8; bf16_t* PPp = (bf16_t*)(ws + WS_PP) + (size_t)b * SEQ * 512 + n * 64 + cg * 8; (void)HLp; (void)PPp;
    f32x2* carry = (f32x2*)(ws + WS_CARRY) + (size_t)b * 64 * 512 + n * 64 + lane;
    float hrun = 0.f;
    if constexpr (FINAL) {
#pragma unroll 8
        for (int cc = 0; cc < c0; ++cc) { const f32x2 v = carry[(size_t)cc * 512]; hrun = v.x * hrun + v.y; }
    }
    asm volatile("s_waitcnt lgkmcnt(0)" ::: "memory");
    u32x4 xn[5], gn[2];
    { const int s0 = c0 * 128;
#pragma unroll
      for (int j = 0; j < 5; ++j) { const int pos = s0 + 2 * rp - 3 + j; xn[j] = (u32x4){0u, 0u, 0u, 0u}; if (pos >= 0) xn[j] = *(const u32x4*)(XR + (size_t)pos * 512); }
      if constexpr (FINAL) { gn[0] = *(const u32x4*)(GR + (size_t)(s0 + 2 * rp) * 512); gn[1] = *(const u32x4*)(GR + (size_t)(s0 + 2 * rp + 1) * 512); } }
    u32x4 dwh[2], dwp[2]; int drow = -1;
#pragma unroll
    for (int rr = 0; rr < 2; ++rr) { dwh[rr] = (u32x4){0u, 0u, 0u, 0u}; dwp[rr] = dwh[rr]; }
    for (int ci = 0; ci < nch; ++ci) {
        const int c = c0 + ci; float Ap = 1.f, Hp = 0.f;
        for (int st = 0; st < 8; ++st) {
            const int s0 = c * 128 + st * 16;
            u32x4 xv[5], gv[2];
#pragma unroll
            for (int j = 0; j < 5; ++j) xv[j] = xn[j];
            if constexpr (FINAL) { gv[0] = gn[0]; gv[1] = gn[1]; }
            { const int s1 = (st == 7 && ci == nch - 1) ? s0 : s0 + 16;
#pragma unroll
              for (int j = 0; j < 5; ++j) { const int pos = s1 + 2 * rp - 3 + j; xn[j] = (u32x4){0u, 0u, 0u, 0u}; if (pos >= 0) xn[j] = *(const u32x4*)(XR + (size_t)pos * 512); }
              if constexpr (FINAL) { gn[0] = *(const u32x4*)(GR + (size_t)(s1 + 2 * rp) * 512); gn[1] = *(const u32x4*)(GR + (size_t)(s1 + 2 * rp + 1) * 512); } }
            { float cw[4][8], cbv[8];
#pragma unroll
              for (int j = 0; j < 4; ++j) { const f32x4 w0 = *(const LAS f32x4*)(CW + j * 64 + cg * 8), w1 = *(const LAS f32x4*)(CW + j * 64 + cg * 8 + 4);
#pragma unroll
                  for (int i = 0; i < 4; ++i) { cw[j][i] = w0[i]; cw[j][4 + i] = w1[i]; } }
              { const f32x4 b0 = *(const LAS f32x4*)(CW + 256 + cg * 8), b1 = *(const LAS f32x4*)(CW + 256 + cg * 8 + 4);
#pragma unroll
                for (int i = 0; i < 4; ++i) { cbv[i] = b0[i]; cbv[4 + i] = b1[i]; } }
#pragma unroll
              for (int rr = 0; rr < 2; ++rr) { float xc[8];
#pragma unroll
                  for (int i = 0; i < 8; ++i) xc[i] = cbv[i];
#pragma unroll
                  for (int j = 0; j < 4; ++j)
#pragma unroll
                      for (int q = 0; q < 4; ++q) { xc[2 * q] += cw[j][2 * q] * bflo(xv[rr + j][q]); xc[2 * q + 1] += cw[j][2 * q + 1] * bfhi(xv[rr + j][q]); }
                  u32x4 w; w.x = cvtpk(xc[0], xc[1]); w.y = cvtpk(xc[2], xc[3]); w.z = cvtpk(xc[4], xc[5]); w.w = cvtpk(xc[6], xc[7]);
                  *(LAS u32x4*)(XCB + (2 * rp + rr) * 72 + cg * 8) = w; } }
            asm volatile("s_waitcnt lgkmcnt(0)" ::: "memory");
            if constexpr (!FINAL) { if (drow >= 0) {
#pragma unroll
                for (int rr = 0; rr < 2; ++rr) { *(u32x4*)(HLp + (size_t)(drow + 2 * rp + rr) * 512) = dwh[rr]; *(u32x4*)(PPp + (size_t)(drow + 2 * rp + rr) * 512) = dwp[rr]; } } }
            { bf16x8 xf[2];
#pragma unroll
              for (int ks = 0; ks < 2; ++ks) xf[ks] = *(const LAS bf16x8*)(XCB + fr * 72 + 32 * ks + 8 * fq);
#pragma unroll
              for (int cb = 0; cb < 4; ++cb) {
                  f32x4 ga = (f32x4){0.f, 0.f, 0.f, 0.f}, gx = ga;
                  ga = __builtin_amdgcn_mfma_f32_16x16x32_bf16(wa[cb][0], xf[0], ga, 0, 0, 0); ga = __builtin_amdgcn_mfma_f32_16x16x32_bf16(wa[cb][1], xf[1], ga, 0, 0, 0);
                  gx = __builtin_amdgcn_mfma_f32_16x16x32_bf16(wx[cb][0], xf[0], gx, 0, 0, 0); gx = __builtin_amdgcn_mfma_f32_16x16x32_bf16(wx[cb][1], xf[1], gx, 0, 0, 0);
                  const int d0 = 16 * cb + 4 * fq;
                  const f32x4 ba = *(const LAS f32x4*)(CW + 320 + d0), bx = *(const LAS f32x4*)(CW + 384 + d0), cdv = *(const LAS f32x4*)(CW + 448 + d0);
                  const u32x2 xw = *(const LAS u32x2*)(XCB + fr * 72 + d0);
                  const float xcv[4] = {bflo(xw.x), bfhi(xw.x), bflo(xw.y), bfhi(xw.y)};
                  f32x4 av, uv;
#pragma unroll
                  for (int i = 0; i < 4; ++i) { const float r = sigmoidf_(ga[i] + ba[i]), ig = sigmoidf_(gx[i] + bx[i]); const float aa = __builtin_amdgcn_exp2f(-cdv[i] * r);
                      av[i] = aa; uv[i] = __builtin_amdgcn_sqrtf(fmaxf(1.0f - aa * aa, 0.f)) * (ig * xcv[i]); }
                  *(LAS f32x4*)(AA + fr * 64 + d0) = av; *(LAS f32x4*)(UU + fr * 64 + d0) = uv;
              } }
            asm volatile("s_waitcnt lgkmcnt(0)" ::: "memory");
            if constexpr (FINAL) {
#pragma unroll
                for (int t = 0; t < 16; ++t) { const float av = AA[t * 64 + lane], uv = UU[t * 64 + lane]; hrun = av * hrun + uv; UU[t * 64 + lane] = hrun; }
                asm volatile("s_waitcnt lgkmcnt(0)" ::: "memory");
#pragma unroll
                for (int rr = 0; rr < 2; ++rr) {
                    const f32x4 h0 = *(const LAS f32x4*)(UU + (2 * rp + rr) * 64 + cg * 8), h1 = *(const LAS f32x4*)(UU + (2 * rp + rr) * 64 + cg * 8 + 4);
                    const float hv[8] = {h0[0], h0[1], h0[2], h0[3], h1[0], h1[1], h1[2], h1[3]}; float o[8];
#pragma unroll
                    for (int q = 0; q < 4; ++q)
#pragma unroll
                        for (int hl = 0; hl < 2; ++hl) { const float x = hl ? bfhi(gv[rr][q]) : bflo(gv[rr][q]); const float y = 0.7978845608028654f * (x + 0.044715f * x * x * x);
                            const float th = 1.0f - 2.0f * __builtin_amdgcn_rcpf(1.0f + __expf(2.0f * y)); o[2 * q + hl] = hv[2 * q + hl] * 0.5f * x * (1.0f + th); }
                    u32x4 w; w.x = cvtpk(o[0], o[1]); w.y = cvtpk(o[2], o[3]); w.z = cvtpk(o[4], o[5]); w.w = cvtpk(o[6], o[7]);
                    *(u32x4*)(MIXp + (size_t)(s0 + 2 * rp + rr) * DM) = w;
                }
            } else {
#pragma unroll
                for (int t = 0; t < 16; ++t) { const float av = AA[t * 64 + lane], uv = UU[t * 64 + lane]; Hp = av * Hp + uv; Ap *= av; UU[t * 64 + lane] = Hp; AA[t * 64 + lane] = Ap; }
                asm volatile("s_waitcnt lgkmcnt(0)" ::: "memory");
#pragma unroll
                for (int rr = 0; rr < 2; ++rr) {
                    const f32x4 h0 = *(const LAS f32x4*)(UU + (2 * rp + rr) * 64 + cg * 8), h1 = *(const LAS f32x4*)(UU + (2 * rp + rr) * 64 + cg * 8 + 4);
                    const f32x4 p0 = *(const LAS f32x4*)(AA + (2 * rp + rr) * 64 + cg * 8), p1 = *(const LAS f32x4*)(AA + (2 * rp + rr) * 64 + cg * 8 + 4);
                    u32x4 wh, wp; wh.x = cvtpk(h0[0], h0[1]); wh.y = cvtpk(h0[2], h0[3]); wh.z = cvtpk(h1[0], h1[1]); wh.w = cvtpk(h1[2], h1[3]);
                    wp.x = cvtpk(p0[0], p0[1]); wp.y = cvtpk(p0[2], p0[3]); wp.z = cvtpk(p1[0], p1[1]); wp.w = cvtpk(p1[2], p1[3]);
                    dwh[rr] = wh; dwp[rr] = wp;
                }
                drow = s0;
            }
            asm volatile("s_waitcnt lgkmcnt(0)" ::: "memory");
        }
        if constexpr (!FINAL) carry[(size_t)c * 512] = (f32x2){Ap, Hp};
    }
    if constexpr (!FINAL) { if (drow >= 0) {
#pragma unroll
        for (int rr = 0; rr < 2; ++rr) { *(u32x4*)(HLp + (size_t)(drow + 2 * rp + rr) * 512) = dwh[rr]; *(u32x4*)(PPp + (size_t)(drow + 2 * rp + rr) * 512) = dwp[rr]; } } }
}

__device__ __forceinline__ void phase_lrufix(unsigned char* ws, LAS unsigned char* lds, int bid, int G, int tid, int lane, int wave, unsigned* queue = nullptr) {
    LAS float* CI = (LAS float*)lds;
    volatile LAS int* qslot = (volatile LAS int*)(lds + LDSCTL_OFF) + 8;
    for (int item = bid, it_ = 0; ; item += G, ++it_) {
        if (queue) { __syncthreads(); if (tid == 0) *qslot = (int)atomicAdd(queue, 1u); __syncthreads(); item = __builtin_amdgcn_readfirstlane(*qslot); }
        if (item >= NB * 32) break;
        const int b = item >> 5, c0 = (item & 31) * 2;
        const f32x2* carry = (const f32x2*)(ws + WS_CARRY) + (size_t)b * 64 * 512 + tid;
        f32x2 cv[64];
#pragma unroll
        for (int cc = 0; cc < 64; ++cc) cv[cc] = carry[(size_t)cc * 512];
        float hrun = 0.f, h1 = 0.f;
#pragma unroll
        for (int cc = 0; cc < 64; ++cc) { if (cc == c0) h1 = hrun; if (cc <= c0) hrun = cv[cc].x * hrun + cv[cc].y; }
        CI[tid] = h1; CI[512 + tid] = hrun;
        __syncthreads();
        float cin[8];
        { const f32x4 c0v = *(const LAS f32x4*)(CI + (wave >> 2) * 512 + lane * 8), c1v = *(const LAS f32x4*)(CI + (wave >> 2) * 512 + lane * 8 + 4);
#pragma unroll
          for (int i = 0; i < 4; ++i) { cin[i] = c0v[i]; cin[4 + i] = c1v[i]; } }
        const size_t row0 = (size_t)b * SEQ + (size_t)c0 * 128 + wave * 32;
        const bf16_t* HLp = (const bf16_t*)(ws + WS_HL) + row0 * 512 + lane * 8; const bf16_t* PPp = (const bf16_t*)(ws + WS_PP) + row0 * 512 + lane * 8;
        const bf16_t* GRp = (const bf16_t*)(ws + WS_Q) + (size_t)4 * MTOK * 512 + row0 * 512 + lane * 8;
        bf16_t* MIXp = (bf16_t*)(ws + WS_MIX) + row0 * DM + 512 + lane * 8;
#pragma unroll 4
        for (int r = 0; r < 32; ++r) {
            const u32x4 hw = __builtin_nontemporal_load((const u32x4*)(HLp + (size_t)r * 512)), pw = __builtin_nontemporal_load((const u32x4*)(PPp + (size_t)r * 512)), gw = __builtin_nontemporal_load((const u32x4*)(GRp + (size_t)r * 512));
            float o[8];
#pragma unroll
            for (int q = 0; q < 4; ++q)
#pragma unroll
                for (int hl = 0; hl < 2; ++hl) { const float hv = (hl ? bfhi(hw[q]) : bflo(hw[q])) + (hl ? bfhi(pw[q]) : bflo(pw[q])) * cin[2 * q + hl];
                    const float x = hl ? bfhi(gw[q]) : bflo(gw[q]); const float y = 0.7978845608028654f * (x + 0.044715f * x * x * x);
                    const float th = 1.0f - 2.0f * __builtin_amdgcn_rcpf(1.0f + __expf(2.0f * y)); o[2 * q + hl] = hv * 0.5f * x * (1.0f + th); }
            u32x4 w; w.x = cvtpk(o[0], o[1]); w.y = cvtpk(o[2], o[3]); w.z = cvtpk(o[4], o[5]); w.w = cvtpk(o[6], o[7]);
            *(u32x4*)(MIXp + (size_t)r * DM) = w;
        }
        __syncthreads();
    }
}

__device__ __forceinline__ s16x4 vtr(const LAS unsigned char* p) { return __builtin_bit_cast(s16x4, __builtin_amdgcn_ds_read_tr16_b64_v4i16((LAS s16x4*)p)); }
__device__ __forceinline__ void glds16(const void* gsrc, unsigned lds_dst) { unsigned keep;
    asm volatile("s_mov_b32 %0, m0\n\ts_mov_b32 m0, %2\n\ts_nop 0\n\tglobal_load_lds_dwordx4 %1, off\n\ts_mov_b32 m0, %0" : "=&s"(keep) : "v"(gsrc), "s"(lds_dst) : "memory"); }
__device__ __forceinline__ int crow(int r, int hi) { return (r & 3) + 8 * (r >> 2) + 4 * hi; }
constexpr int AT_SLOT = 32768, AT_STRIDE = 132;
constexpr int AT_KSLOT = 16384, AT_VBASE = 49152, AT_VSLOT = 16384, AT_WL = RING_BYTES + 1024;
template <bool DOQK, bool DOPV>
__device__ __forceinline__ void attn_step(const LAS unsigned char* kb, const LAS unsigned char* vb, const int (&vad)[4], const int vdl, const bf16x8 (&qf)[4], const f32x16& negsb, f32x16 (&o)[4], bf16x8 (&pa)[2][2], float& lsum) {
    f32x16 p0 = negsb, p1 = negsb; bf16x8 kf[4]; s16x4 vl[5], vh[5];
#define AT_VRD(g) do { if constexpr (DOPV) { if ((g) < 16) { vl[(g) % 5] = vtr(vb + vad[(g) & 3] + 4096 * ((g) >> 2)); vh[(g) % 5] = vtr(vb + vad[(g) & 3] + vdl + 4096 * ((g) >> 2)); } } } while (0)
#define AT_PVG(g) do { if constexpr (DOPV) { const s16x4 a_ = vl[(g) % 5], b_ = vh[(g) % 5]; const bf16x8 vf_ = (bf16x8){a_[0], a_[1], a_[2], a_[3], b_[0], b_[1], b_[2], b_[3]}; \
        o[(g) & 3] = __builtin_amdgcn_mfma_f32_32x32x16_bf16(pa[(g) >> 3][((g) >> 2) & 1], vf_, o[(g) & 3], 0, 0, 0); } } while (0)
#define AT_KRD(d0) do { if constexpr (DOQK) { kf[2 * ((d0) & 1)] = *(const LAS bf16x8*)(kb + (d0) * 2048); kf[2 * ((d0) & 1) + 1] = *(const LAS bf16x8*)(kb + (d0) * 2048 + 512); } } while (0)
#define AT_QK(d0) do { if constexpr (DOQK) { p0 = __builtin_amdgcn_mfma_f32_32x32x16_bf16(kf[2 * ((d0) & 1)], qf[d0], p0, 0, 0, 0); p1 = __builtin_amdgcn_mfma_f32_32x32x16_bf16(kf[2 * ((d0) & 1) + 1], qf[d0], p1, 0, 0, 0); } } while (0)
    AT_VRD(0); AT_VRD(1); AT_KRD(0); AT_KRD(1); AT_VRD(2); AT_VRD(3);
    __builtin_amdgcn_sched_barrier(0);
    AT_VRD(4); AT_PVG(0); __builtin_amdgcn_sched_barrier(0);
    AT_VRD(5); AT_PVG(1); __builtin_amdgcn_sched_barrier(0);
    AT_VRD(6); AT_PVG(2); __builtin_amdgcn_sched_barrier(0);
    AT_QK(0); AT_KRD(2); __builtin_amdgcn_sched_barrier(0);
    AT_VRD(7); AT_PVG(3); __builtin_amdgcn_sched_barrier(0);
    AT_QK(1); AT_KRD(3); __builtin_amdgcn_sched_barrier(0);
    AT_VRD(8); AT_PVG(4); __builtin_amdgcn_sched_barrier(0);
    AT_VRD(9); AT_PVG(5); __builtin_amdgcn_sched_barrier(0);
    AT_QK(2); AT_QK(3);
    __builtin_amdgcn_sched_barrier(0);
#undef AT_KRD
#undef AT_QK
    float ls = 0.f;
#define AT_EXP(P, i) do { if constexpr (DOQK) { P[i] = __builtin_amdgcn_exp2f(P[i]); ls += P[i]; } } while (0)
    AT_VRD(10); AT_PVG(6);  AT_EXP(p0, 0);  AT_EXP(p0, 1);  AT_EXP(p0, 2);  __builtin_amdgcn_sched_barrier(0);
    AT_VRD(11); AT_PVG(7);  AT_EXP(p0, 3);  AT_EXP(p0, 4);  AT_EXP(p0, 5);  __builtin_amdgcn_sched_barrier(0);
    AT_VRD(12); AT_PVG(8);  AT_EXP(p0, 6);  AT_EXP(p0, 7);  AT_EXP(p0, 8);  __builtin_amdgcn_sched_barrier(0);
    AT_VRD(13); AT_PVG(9);  AT_EXP(p0, 9);  AT_EXP(p0, 10); AT_EXP(p0, 11); __builtin_amdgcn_sched_barrier(0);
    AT_VRD(14); AT_PVG(10); AT_EXP(p0, 12); AT_EXP(p0, 13); AT_EXP(p0, 14); AT_EXP(p0, 15); __builtin_amdgcn_sched_barrier(0);
    AT_VRD(15); AT_PVG(11); AT_EXP(p1, 0);  AT_EXP(p1, 1);  AT_EXP(p1, 2);  AT_EXP(p1, 3);  __builtin_amdgcn_sched_barrier(0);
    AT_PVG(12); AT_EXP(p1, 4);  AT_EXP(p1, 5);  AT_EXP(p1, 6);  __builtin_amdgcn_sched_barrier(0);
    AT_PVG(13); AT_EXP(p1, 7);  AT_EXP(p1, 8);  AT_EXP(p1, 9);  __builtin_amdgcn_sched_barrier(0);
    AT_PVG(14); AT_EXP(p1, 10); AT_EXP(p1, 11); AT_EXP(p1, 12); __builtin_amdgcn_sched_barrier(0);
    AT_PVG(15); AT_EXP(p1, 13); AT_EXP(p1, 14); AT_EXP(p1, 15); __builtin_amdgcn_sched_barrier(0);
#undef AT_VRD
#undef AT_PVG
#undef AT_EXP
    if constexpr (DOQK) {
        lsum += ls;
#pragma unroll
        for (int ks = 0; ks < 2; ++ks) { u32x4 w0, w1;
#pragma unroll
            for (int i = 0; i < 4; ++i) { w0[i] = cvtpk(p0[8 * ks + 2 * i], p0[8 * ks + 2 * i + 1]); w1[i] = cvtpk(p1[8 * ks + 2 * i], p1[8 * ks + 2 * i + 1]); }
            pa[0][ks] = __builtin_bit_cast(bf16x8, w0); pa[1][ks] = __builtin_bit_cast(bf16x8, w1); }
    }
}
constexpr int CV_ITEMS1 = NEXP * 64 * 32, CV_ITEMS = CV_ITEMS1 + NEXP * 64 * 16, CV_PER_WAVE = CV_ITEMS / 1024, CV_LDS = 114688;
static_assert(CV_PER_WAVE * 5 <= 520 - 3, "conversion items must fit the attention phase's tile steps");
__device__ __forceinline__ void conv_issue(const Args& a, unsigned ldsbuf, int it, int lane) {
    const bool w1 = it < CV_ITEMS1; const int i2 = w1 ? it : it - CV_ITEMS1;
    const int N = w1 ? 2048 : 1024, lgn = w1 ? 5 : 4, nb = i2 & ((1 << lgn) - 1), kb = (i2 >> lgn) & 63, e = i2 >> (lgn + 6);
    const float* base = (w1 ? a.in[I_W1] : a.in[I_W2]) + ((size_t)e * 1024 + kb * 16) * N + nb * 64;
#pragma unroll
    for (int j = 0; j < 4; ++j) { const int R = 4 * j + (lane >> 4), chunk = (lane & 15) ^ R; glds16(base + (size_t)R * N + chunk * 4, ldsbuf + j * 1024u); }
}
__device__ __forceinline__ void conv_finish(unsigned char* ws, const LAS unsigned char* buf, int it, int lane) {
    const bool w1 = it < CV_ITEMS1; const int i2 = w1 ? it : it - CV_ITEMS1;
    const int lgn = w1 ? 5 : 4, nb = i2 & ((1 << lgn) - 1), kb = (i2 >> lgn) & 63, e = i2 >> (lgn + 6);
    const int c = lane >> 2, e4 = lane & 3;
    float v[16];
#pragma unroll
    for (int r = 0; r < 16; ++r) v[r] = *(const LAS float*)(buf + r * 256 + ((c ^ r) & 15) * 16 + e4 * 4) * WSCALE;
    const float lo[8] = {v[0], v[1], v[2], v[3], v[4], v[5], v[6], v[7]}, hi[8] = {v[8], v[9], v[10], v[11], v[12], v[13], v[14], v[15]};
    const u32x2 p0 = pack_fp8x8(lo), p1 = pack_fp8x8(hi);
    unsigned char* dst = w1 ? (unsigned char*)(ws + WS_W1) + ((size_t)e * 2048 + map_row(2, nb * 64 + lane)) * 1024 + kb * 16
                            : (unsigned char*)(ws + WS_W2) + ((size_t)e * 1024 + nb * 64 + lane) * 1024 + kb * 16;
    *(u32x4*)dst = (u32x4){p0.x, p0.y, p1.x, p1.y};
}
struct ConvState { int ph, n; };
__device__ __forceinline__ void attn_unit2(const Args& a, unsigned char* ws, LAS unsigned char* lds, int b, int h, int qb, int lane, int wave, ConvState& cs, int cw) {
    const bf16_t* Q = (const bf16_t*)(ws + WS_Q); const bf16_t* Kb = Q + (size_t)MTOK * 512; const bf16_t* Vb = Kb + (size_t)MTOK * 512;
    const float* scal = (const float*)(ws + WS_SCAL); const float lam = scal[0], SB = scal[1];
    const int rg = wave >> 1, t = wave & 1, r32 = lane & 31, hi = lane >> 5;
    const size_t tok0 = (size_t)b * SEQ + (size_t)qb * 128;
    bf16x8 qf[4];
    { const bf16_t* qp = Q + (tok0 + rg * 32 + r32) * 512 + (2 * h + t) * 64 + 8 * hi;
#pragma unroll
      for (int d0 = 0; d0 < 4; ++d0) qf[d0] = *(const bf16x8*)(qp + 16 * d0); }
    const int NT = 2 * qb + 2, my_last = 2 * qb + (rg >> 1);
    const unsigned koff0 = (unsigned)((((2 * h) * 8 + wave) * 64 + lane) * 8) * 2u;
    unsigned voff0; { const int row = 4 * wave + (lane >> 4), ch = (lane & 15) ^ (((row & 3) << 2) | ((row >> 2) & 3)); voff0 = (unsigned)((h * 64 + row) * 128 + ch * 8) * 2u; }
    const char* Kt = (const char*)(Kb + (size_t)b * SEQ * 512); const char* Vt = (const char*)(Vb + (size_t)b * SEQ * 512);
    const unsigned ldsb = (unsigned)(uintptr_t)lds + (unsigned)wave * 1024u;
#define AT2_DMA(kt, ks_, vs_) do { const size_t to_ = (size_t)(kt) * 65536; const unsigned kb_ = (unsigned)__builtin_amdgcn_readfirstlane((int)(ldsb + (unsigned)(ks_) * AT_KSLOT)), vb_ = (unsigned)__builtin_amdgcn_readfirstlane((int)(ldsb + AT_VBASE + (unsigned)(vs_) * AT_VSLOT)); \
        glds16(Kt + to_ + koff0, kb_); glds16(Kt + to_ + 8192 + koff0, kb_ + 8192u); glds16(Vt + to_ + voff0, vb_); glds16(Vt + to_ + 8192 + voff0, vb_ + 8192u); } while (0)
    const int blk = (lane >> 4) & 1, qq = (lane & 15) >> 2, pp = lane & 3;
    int vad[4];
#pragma unroll
    for (int c = 0; c < 4; ++c) vad[c] = 256 * (4 * hi + qq) + 8 * (pp & 1) + 16 * ((((c ^ qq) & 3) << 2) | ((2 * blk + (pp >> 1)) ^ hi));
    const int vdl = 2048 + 16 * ((((2 * blk + (pp >> 1)) ^ (2 + hi)) & 3) - (((2 * blk + (pp >> 1)) ^ hi) & 3));
    const int kad = t * 8192 + hi * 1024 + r32 * 16;
    f32x16 o[4];
#pragma unroll
    for (int c = 0; c < 4; ++c)
#pragma unroll
        for (int r = 0; r < 16; ++r) o[c][r] = 0.f;
    float lsum = 0.f;
    f32x16 negsb;
#pragma unroll
    for (int r = 0; r < 16; ++r) negsb[r] = -SB;
    bf16x8 pa[2][2];
#pragma unroll
    for (int i = 0; i < 2; ++i)
#pragma unroll
        for (int j = 0; j < 2; ++j) pa[i][j] = (bf16x8){0, 0, 0, 0, 0, 0, 0, 0};
    AT2_DMA(0, 0, 0); AT2_DMA(1, 1, 1);
    asm volatile("" : "+v"(qf[0]), "+v"(qf[1]), "+v"(qf[2]), "+v"(qf[3]));
    int ksl = 0, vsl = 0, vprev = 0;
    for (int kt = 0; kt <= NT; ++kt) {
        if (kt < NT) {
            if (kt + 1 < NT) asm volatile("s_waitcnt vmcnt(4)" ::: "memory"); else asm volatile("s_waitcnt vmcnt(0)" ::: "memory");
            __builtin_amdgcn_s_barrier();
            asm volatile("" ::: "memory");
            if (wave < 4 && cw >= 0) {
                if (cs.n < CV_PER_WAVE) {
                    if (cs.ph == 0) conv_issue(a, (unsigned)__builtin_amdgcn_readfirstlane((int)((unsigned)(uintptr_t)lds + CV_LDS + wave * 4096)), cs.n * 1024 + cw, lane);
                    else if (cs.ph == 2) { conv_finish(ws, lds + CV_LDS + wave * 4096, cs.n * 1024 + cw, lane); ++cs.n; }
                }
                cs.ph = cs.ph == 4 ? 0 : cs.ph + 1;
            }
            if (kt + 2 < NT) { const int k2 = ksl >= 1 ? ksl - 1 : 2, v2 = (vsl + 2) & 3; AT2_DMA(kt + 2, k2, v2); }
        }
        const LAS unsigned char* kb = lds + ksl * AT_KSLOT + kad; const LAS unsigned char* vb = lds + AT_VBASE + vprev * AT_VSLOT;
        if (kt <= my_last + 1) { float ls = 0.f; attn_step<true, true>(kb, vb, vad, vdl, qf, negsb, o, pa, ls); lsum += (kt <= my_last) ? ls : 0.f; }
        vprev = vsl; ksl = ksl == 2 ? 0 : ksl + 1; vsl = (vsl + 1) & 3;
    }
#undef AT2_DMA
    lsum += __shfl_xor(lsum, 32);
    asm volatile("s_waitcnt lgkmcnt(0)" ::: "memory"); __builtin_amdgcn_s_barrier(); asm volatile("" ::: "memory");
    LAS float* wl = (LAS float*)(lds + AT_WL) + wave * 32;
    if (hi == 0) wl[r32] = lsum;
    asm volatile("s_waitcnt lgkmcnt(0)" ::: "memory");
    float linv[16];
#pragma unroll
    for (int r = 0; r < 16; ++r) linv[r] = (t ? lam : 1.0f) / wl[crow(r, hi)];
    LAS float* ST = (LAS float*)lds + rg * (32 * AT_STRIDE);
    if (t == 1) {
#pragma unroll
        for (int c = 0; c < 4; ++c)
#pragma unroll
            for (int r = 0; r < 16; ++r) ST[crow(r, hi) * AT_STRIDE + 32 * c + r32] = o[c][r] * linv[r];
    }
    asm volatile("s_waitcnt lgkmcnt(0)" ::: "memory"); __builtin_amdgcn_s_barrier(); asm volatile("" ::: "memory");
    if (t == 0) {
#pragma unroll
        for (int c = 0; c < 4; ++c)
#pragma unroll
            for (int r = 0; r < 16; ++r) { const int ad = crow(r, hi) * AT_STRIDE + 32 * c + r32; ST[ad] = o[c][r] * linv[r] - ST[ad]; }
    }
    f32x4 gsub[8];
    { const f32x4* gp = (const f32x4*)(a.in[I_SUBG] + (lane & 3) * 32);
#pragma unroll
      for (int i = 0; i < 8; ++i) gsub[i] = gp[i]; }
    asm volatile("s_waitcnt lgkmcnt(0)" ::: "memory"); __builtin_amdgcn_s_barrier(); asm volatile("" ::: "memory");
    {
        const int row = 16 * t + (lane >> 2), dseg = lane & 3;
        const LAS f32x4* rp = (const LAS f32x4*)(ST + row * AT_STRIDE + dseg * 32);
        f32x4 v[8]; float ss = 0.f;
#pragma unroll
        for (int i = 0; i < 8; ++i) { v[i] = rp[i]; ss += (v[i][0] * v[i][0] + v[i][1] * v[i][1]) + (v[i][2] * v[i][2] + v[i][3] * v[i][3]); }
        ss += __shfl_xor(ss, 1); ss += __shfl_xor(ss, 2);
        const float rs = 0.8f / sqrtf(ss * (1.0f / 128.0f) + 1e-5f);
        bf16_t* op = (bf16_t*)(ws + WS_MIX) + (tok0 + rg * 32 + row) * DM + h * 128 + dseg * 32;
#pragma unroll
        for (int i = 0; i < 4; ++i) { const f32x4 g0 = gsub[2 * i], g1 = gsub[2 * i + 1]; const f32x4 x0 = v[2 * i] * rs * g0, x1 = v[2 * i + 1] * rs * g1;
            u32x4 w; w.x = cvtpk(x0[0], x0[1]); w.y = cvtpk(x0[2], x0[3]); w.z = cvtpk(x1[0], x1[1]); w.w = cvtpk(x1[2], x1[3]); *(u32x4*)(op + 8 * i) = w; }
    }
    asm volatile("s_waitcnt lgkmcnt(0)" ::: "memory"); __builtin_amdgcn_s_barrier(); asm volatile("" ::: "memory");
}

#define TOPK_INS(v, i, LEX) do { const float v_ = (v); const int i_ = (i); \
    const bool c3_ = v_ > tv3 || (LEX && v_ == tv3 && i_ < ti3), c2_ = v_ > tv2 || (LEX && v_ == tv2 && i_ < ti2), c1_ = v_ > tv1 || (LEX && v_ == tv1 && i_ < ti1), c0_ = v_ > tv0 || (LEX && v_ == tv0 && i_ < ti0); \
    tv3 = c2_ ? tv2 : (c3_ ? v_ : tv3); ti3 = c2_ ? ti2 : (c3_ ? i_ : ti3); tv2 = c1_ ? tv1 : (c2_ ? v_ : tv2); ti2 = c1_ ? ti1 : (c2_ ? i_ : ti2); \
    tv1 = c0_ ? tv0 : (c1_ ? v_ : tv1); ti1 = c0_ ? ti0 : (c1_ ? i_ : ti1); tv0 = c0_ ? v_ : tv0; ti0 = c0_ ? i_ : ti0; } while (0)
__device__ __forceinline__ void phase_router(const Args& a, unsigned char* ws, LAS unsigned char* lds, int bid, int G, int tid, int lane, int wave) {
    LAS unsigned char* up = lds + RING_BYTES + 1024;
    LAS float* A2 = (LAS float*)up; LAS float* SH = A2 + DM; LAS float* CV = SH + DM; LAS int* hist = (LAS int*)(CV + 32); LAS int* basev = hist + 32; LAS int* er = basev + 32;
    const float* modv = (const float*)(ws + WS_MODV); const bf16_t* x1 = (const bf16_t*)(ws + WS_X1); const float* ssq = (const float*)(ws + WS_SS);
    unsigned* cnt = (unsigned*)(ws + WS_CTL) + CW_CNT; unsigned char* XN = (unsigned char*)(ws + WS_XN);
    for (int tile = bid; tile < MTOK / 256; tile += G) {
        const int b = tile >> 5;
        for (int col = tid; col < DM; col += 512) { A2[col] = a.in[I_N2G][col] * (1.0f + modv[(size_t)b * 6144 + 4 * DM + col]); SH[col] = modv[(size_t)b * 6144 + 3 * DM + col]; }
        if (tid < 32) hist[tid] = 0;
        __syncthreads();
        if (tid < 32) CV[tid] = a.in[I_BR][tid];
        __syncthreads();
        const int r32 = lane & 31, hi = lane >> 5, rl = wave * 32 + r32; const size_t row = (size_t)tile * 256 + rl;
        float ss = 0.f;
        { const f32x4* sp = (const f32x4*)(ssq + row * 16);
#pragma unroll
          for (int i = 0; i < 4; ++i) { const f32x4 v = sp[i]; ss += (v[0] + v[1]) + (v[2] + v[3]); } }
        const float rstd = 1.0f / sqrtf(ss * (1.0f / DM) + 1e-6f);
        const int lr = lane >> 4, ls = lane & 15;
        LAS float* rsT = (LAS float*)(up + 13696) + wave * 32; if (hi == 0) rsT[r32] = rstd;
        LAS float* xs = (LAS float*)(lds + wave * 8192);
        asm volatile("s_waitcnt lgkmcnt(0)" ::: "memory");
        const char* xbase = (const char*)(x1 + ((size_t)tile * 256 + wave * 32) * DM); unsigned char* hbase = XN + ((size_t)tile * 256 + wave * 32) * DM;
        const unsigned xlo = (unsigned)(lr * DM + 4 * ls) * 2u, hlo = (unsigned)(lr * DM + 4 * ls);
        const u32x4* wfr = (const u32x4*)(ws + WS_WRF) + lane;
        u32x2 cx[8], nx[8];
#pragma unroll
        for (int j = 0; j < 8; ++j) cx[j] = *(const u32x2*)(xbase + (size_t)(4 * j) * DM * 2 + xlo);
        f32x16 acc;
#pragma unroll
        for (int r = 0; r < 16; ++r) acc[r] = 0.f;
        for (int i = 0; i < 16; ++i) {
            const int inx = i < 15 ? i + 1 : 15;
#pragma unroll
            for (int j = 0; j < 8; ++j) nx[j] = *(const u32x2*)(xbase + ((size_t)(4 * j) * DM + 64 * inx) * 2 + xlo);
            u32x4 wh4[4], wl4[4];
#pragma unroll
            for (int sI = 0; sI < 4; ++sI) { wh4[sI] = wfr[(4 * i + sI) * 64]; wl4[sI] = wfr[4096 + (4 * i + sI) * 64]; }
            const f32x4 a2v = *(const LAS f32x4*)(A2 + 64 * i + 4 * ls), shv = *(const LAS f32x4*)(SH + 64 * i + 4 * ls);
#pragma unroll
            for (int j = 0; j < 8; ++j) { const int rr = 4 * j + lr; const f32x4 xf = (f32x4){bflo(cx[j].x), bfhi(cx[j].x), bflo(cx[j].y), bfhi(cx[j].y)}; const f32x4 hm = xf * rsT[rr] * a2v + shv;
                int w8 = 0; w8 = __builtin_amdgcn_cvt_pk_fp8_f32(hm[0], hm[1], w8, false); w8 = __builtin_amdgcn_cvt_pk_fp8_f32(hm[2], hm[3], w8, true);
                *(unsigned*)(hbase + (size_t)(4 * j) * DM + 64 * i + hlo) = (unsigned)w8;
                *(LAS f32x4*)(xs + rr * 64 + ((ls ^ (rr & 15)) * 4)) = hm; }
            asm volatile("s_waitcnt lgkmcnt(0)" ::: "memory");
#pragma unroll
            for (int sI = 0; sI < 4; ++sI) {
                const int c0 = 4 * sI + 2 * hi;
                const f32x4 ha = *(const LAS f32x4*)(xs + r32 * 64 + ((c0 ^ (r32 & 15)) * 4)), hb = *(const LAS f32x4*)(xs + r32 * 64 + (((c0 + 1) ^ (r32 & 15)) * 4));
                u32x4 wh; wh.x = cvtpk(ha[0], ha[1]); wh.y = cvtpk(ha[2], ha[3]); wh.z = cvtpk(hb[0], hb[1]); wh.w = cvtpk(hb[2], hb[3]);
                u32x4 wl2; wl2.x = cvtpk(ha[0] - bflo(wh.x), ha[1] - bfhi(wh.x)); wl2.y = cvtpk(ha[2] - bflo(wh.y), ha[3] - bfhi(wh.y)); wl2.z = cvtpk(hb[0] - bflo(wh.z), hb[1] - bfhi(wh.z)); wl2.w = cvtpk(hb[2] - bflo(wh.w), hb[3] - bfhi(wh.w));
                const bf16x8 fh = __builtin_bit_cast(bf16x8, wh), fl = __builtin_bit_cast(bf16x8, wl2), wfh = __builtin_bit_cast(bf16x8, wh4[sI]), wfl = __builtin_bit_cast(bf16x8, wl4[sI]);
                acc = __builtin_amdgcn_mfma_f32_32x32x16_bf16(wfh, fh, acc, 0, 0, 0); acc = __builtin_amdgcn_mfma_f32_32x32x16_bf16(wfl, fh, acc, 0, 0, 0); acc = __builtin_amdgcn_mfma_f32_32x32x16_bf16(wfh, fl, acc, 0, 0, 0);
            }
            asm volatile("s_waitcnt lgkmcnt(0)" ::: "memory");
#pragma unroll
            for (int j = 0; j < 8; ++j) cx[j] = nx[j];
        }
        float tv0 = -INFINITY, tv1 = -INFINITY, tv2 = -INFINITY, tv3 = -INFINITY; int ti0 = 0, ti1 = 0, ti2 = 0, ti3 = 0;
#pragma unroll
        for (int r = 0; r < 16; ++r) { const int e = (r & 3) + 8 * (r >> 2) + 4 * hi; TOPK_INS(acc[r] + CV[e], e, false); }
        { const float p0 = __shfl_xor(tv0, 32), p1 = __shfl_xor(tv1, 32), p2 = __shfl_xor(tv2, 32), p3 = __shfl_xor(tv3, 32); const int q0 = __shfl_xor(ti0, 32), q1 = __shfl_xor(ti1, 32), q2 = __shfl_xor(ti2, 32), q3 = __shfl_xor(ti3, 32);
          TOPK_INS(p0, q0, true); TOPK_INS(p1, q1, true); TOPK_INS(p2, q2, true); TOPK_INS(p3, q3, true); }
        if (hi == 0) { const float e1 = expf(tv1 - tv0), e2 = expf(tv2 - tv0), e3 = expf(tv3 - tv0); const float inv = 1.0f / (1.0f + e1 + e2 + e3);
            *(f32x4*)((float*)(ws + WS_GATE) + row * 4) = (f32x4){inv, e1 * inv, e2 * inv, e3 * inv};
            er[rl * 4 + 0] = ti0 | (atomicAdd((int*)&hist[ti0], 1) << 5); er[rl * 4 + 1] = ti1 | (atomicAdd((int*)&hist[ti1], 1) << 5);
            er[rl * 4 + 2] = ti2 | (atomicAdd((int*)&hist[ti2], 1) << 5); er[rl * 4 + 3] = ti3 | (atomicAdd((int*)&hist[ti3], 1) << 5); }
        __syncthreads();
        if (tid < 32) basev[tid] = (int)atomicAdd(&cnt[tid], (unsigned)hist[tid]);
        __syncthreads();
        for (int i = tid; i < 1024; i += 512) { const int v = er[i], e = v & 31; ((int*)(ws + WS_TOPI))[(size_t)tile * 1024 + i] = e; ((int*)(ws + WS_POS))[(size_t)tile * 1024 + i] = basev[e] + (v >> 5); }
        __syncthreads();
    }
}

__device__ __forceinline__ void phase_fill(const Args& a, LAS unsigned char* lds, int bid, int G, int tid) {
    unsigned char* ws = a.ws;
    LAS int* pst = (LAS int*)lds; LAS int* cn = pst + 32;
    const unsigned* cnt = (const unsigned*)(ws + WS_CTL) + CW_CNT;
    int* rowtok = (int*)(ws + WS_ROWTOK); float* rowg = (float*)(ws + WS_ROWG); int* tinfo = (int*)(ws + WS_TILE);
    if (tid < 32) cn[tid] = (int)cnt[tid];
    __syncthreads();
    if (tid == 0) { int sacc = 0; for (int e = 0; e < 32; ++e) { pst[e] = sacc; sacc += (cn[e] + 255) & ~255; } }
    __syncthreads();
    for (int tile = bid; tile < MTOK / 256; tile += G) {
        for (int i = tid; i < 1024; i += 512) { const size_t k = (size_t)tile * 1024 + i; const int e = ((const int*)(ws + WS_TOPI))[k]; const int pos = pst[e] + ((const int*)(ws + WS_POS))[k];
            ((int*)(ws + WS_POS))[k] = pos; rowtok[pos] = (int)(k >> 2); rowg[pos] = ((const float*)(ws + WS_GATE))[k]; }
    }
    for (int e = bid; e < 32; e += G) { const int s0 = pst[e] + cn[e], s1 = pst[e] + ((cn[e] + 255) & ~255);
        for (int r = s0 + tid; r < s1; r += 512) { rowtok[r] = 0; rowg[r] = 0.f; } }
    if (bid == 0) {
        for (int e = tid; e < 32; e += 512) { const int t0 = pst[e] >> 8, t1 = (pst[e] + ((cn[e] + 255) & ~255)) >> 8; for (int t = t0; t < t1; ++t) tinfo[16 + t] = e; }
        if (tid == 0) tinfo[0] = (pst[31] + ((cn[31] + 255) & ~255)) >> 8;
    }
}

__device__ __forceinline__ void phase_combine(const Args& a, int bid, int G, int lane, int wave, float gmul = 1.0f) {
    unsigned char* ws = a.ws;
    const unsigned char* Y = (const unsigned char*)(ws + WS_Y); const int* posv = (const int*)(ws + WS_POS); const float* modv = (const float*)(ws + WS_MODV);
    for (int rt = bid; rt < MTOK / 128; rt += G) {
        const size_t rbase = (size_t)rt * 128 + wave * 16; const int b = (int)(rbase >> 13);
        f32x4 g2[4];
#pragma unroll
        for (int j = 0; j < 4; ++j) g2[j] = *(const f32x4*)(modv + (size_t)b * 6144 + 5 * DM + 4 * lane + 256 * j) * (YINV * gmul);
        const int pl = posv[rbase * 4 + lane];
        const u32x2* xp0 = (const u32x2*)((const bf16_t*)(ws + WS_X1) + rbase * DM) + lane; f32x4* op0 = (f32x4*)(a.out + rbase * DM) + lane;
        unsigned ya[4][4], yb[4][4]; u32x2 xa[4], xb[4];
#define CB_LOAD(r, YS, XS) do { _Pragma("unroll") for (int j = 0; j < 4; ++j) { const int ps_ = __builtin_amdgcn_readlane(pl, 4 * (r) + j); const unsigned* yp_ = (const unsigned*)(Y + (size_t)ps_ * DM) + lane; \
            _Pragma("unroll") for (int q = 0; q < 4; ++q) YS[j][q] = __builtin_nontemporal_load(yp_ + 64 * q); } \
        _Pragma("unroll") for (int q = 0; q < 4; ++q) XS[q] = __builtin_nontemporal_load(xp0 + (size_t)(r) * (DM / 4) + 64 * q); } while (0)
#define CB_STORE(r, YS, XS) do { f32x4 sacc_[4]; _Pragma("unroll") for (int q = 0; q < 4; ++q) sacc_[q] = (f32x4){0.f, 0.f, 0.f, 0.f}; \
        _Pragma("unroll") for (int j = 0; j < 4; ++j) _Pragma("unroll") for (int q = 0; q < 4; ++q) { const f32x2 lo_ = __builtin_amdgcn_cvt_pk_f32_fp8((int)YS[j][q], false), hi_ = __builtin_amdgcn_cvt_pk_f32_fp8((int)YS[j][q], true); \
            sacc_[q][0] += lo_[0]; sacc_[q][1] += lo_[1]; sacc_[q][2] += hi_[0]; sacc_[q][3] += hi_[1]; } \
        _Pragma("unroll") for (int q = 0; q < 4; ++q) { const f32x4 xv_ = (f32x4){bflo(XS[q].x), bfhi(XS[q].x), bflo(XS[q].y), bfhi(XS[q].y)}; \
            __builtin_nontemporal_store(xv_ + g2[q] * sacc_[q], op0 + (size_t)(r) * (DM / 4) + 64 * q); } } while (0)
        CB_LOAD(0, ya, xa);
#pragma unroll 1
        for (int r = 0; r < 16; r += 2) {
            CB_LOAD(r + 1, yb, xb);
            CB_STORE(r, ya, xa);
            const int r2 = r + 2 < 16 ? r + 2 : 15;
            CB_LOAD(r2, ya, xa);
            CB_STORE(r + 1, yb, xb);
        }
#undef CB_LOAD
#undef CB_STORE
    }
}

__global__ void __launch_bounds__(NWAVES * 64, 2) fwd_kernel(Args args) {
    extern __shared__ __attribute__((aligned(16))) unsigned char lds_raw[];
    LAS unsigned char* lds = (LAS unsigned char*)lds_raw;
    const int G = gridDim.x, bid = blockIdx.x;
    volatile LAS unsigned* MISC = (volatile LAS unsigned*)(lds + LDSCTL_OFF);
    for (int u = threadIdx.x; u < 16; u += NWAVES * 64) MISC[u] = 0u;
    __syncthreads();
    XcdBarrier bar; bar.bar = (unsigned*)(args.ws + WS_CTL) + CW_BAR; bar.x = 0; bar.st = nullptr;
    if (N_LAUNCHES == 1) bar = xcd_barrier_post((unsigned*)(args.ws + WS_CTL) + CW_BAR, MISC + 2);
    const int lo = args.ph_lo, hi = args.ph_hi;
#ifndef PH_MASK
#define PH_MASK 0x7ff
#endif
#define IN(k) (((PH_MASK >> (k)) & 1) && lo <= (k) && (k) < hi)
#ifndef REP_MASK
#define REP_MASK 0
#endif
#define REPS(k) for (int rep_ = 0; rep_ < (((REP_MASK >> (k)) & 1) ? 2 : 1); ++rep_, __syncthreads())
#define SEAM(k) do { if (IN(k) && IN((k) + 1)) xcd_barrier(bar); } while (0)
#define PHASE_VARS int tid = threadIdx.x; asm volatile("" : "+v"(tid)); const int lane = tid & 63, wave = __builtin_amdgcn_readfirstlane(tid >> 6); unsigned char* ws = args.ws; { size_t z_ = 0; asm volatile("" : "+s"(z_)); ws += z_; } (void)lane; (void)wave; (void)ws;

    if (IN(0)) REPS(0) { PHASE_VARS phase_mod(args, lds, bid, G, tid, lane, wave); } SEAM(0);
    if (IN(1)) REPS(1) { PHASE_VARS phase_hn(args, lds, bid, G, tid, lane, wave); phase_misc(args, lds, bid, G, tid, lane, wave); if (G != 256) convert_expert_weights(args, lds, bid, G, lane, wave); } SEAM(1);
    if (IN(2)) REPS(2) {
        PHASE_VARS
        pg8::StaticOrder S; S.init(MTOK, INW, DM, G, bid, ws + WS_XN, ws + WS_WIN);
        EpiInProj E{(bf16_t*)(ws + WS_Q), args.in[I_QG], args.in[I_KG], (const float*)(ws + WS_ROPE), (const float*)(ws + WS_ROPE) + SEQ * 32};
        pg8::gemm_phase<EpiInProj, pg8::StaticOrder, false, true>(lds, DM, S, E);
    } SEAM(2);
    if (IN(3)) REPS(3) {
        PHASE_VARS
        for (int gw = bid * NWAVES + wave; gw < 2048; gw += G * NWAVES) lru_wave<false>(args, ws, lds + wave * LRU_WAVE_LDS, gw >> 8, (gw >> 5) & 7, (gw & 31) * 2, 2, lane);
        asm volatile("s_waitcnt vmcnt(0)" ::: "memory");
        __syncthreads();
        unsigned* hob = (unsigned*)(ws + WS_CTL) + CW_HO;
        if (N_LAUNCHES == 1 && tid == 0) {
            const unsigned nloc = MISC[2];
            const unsigned old = xb_add(&hob[64 * bar.x], 1u);
            if (old + 1u == nloc) { __builtin_amdgcn_fence(__ATOMIC_RELEASE, "agent"); asm volatile("s_waitcnt vmcnt(0)" ::: "memory"); (void)xb_add(&hob[1024], 1u); }
        }
        {
            const int nu = (G == 256) ? 8 : (NB * 4 * 64 - bid + G - 1) / G;
            ConvState cs{0, 0};
            if (wave >= 4) __builtin_amdgcn_s_setprio(1);
            for (int u = 0; u < nu; ++u) { int bh, qb;
                if (G == 256) { bh = 4 * (bid & 7) + (u >> 1); qb = (u & 1) ? (bid >> 3) : 63 - (bid >> 3); } else { const int uu = bid + u * G; bh = uu >> 6; qb = 63 - (uu & 63); }
                attn_unit2(args, ws, lds, bh >> 2, bh & 3, qb, lane, wave, cs, (G == 256) ? bid * 4 + wave : -1); }
            __builtin_amdgcn_s_setprio(0);
        }
        if (N_LAUNCHES == 1) {
            if (tid == 0) { const unsigned nx = MISC[3]; XB_SPIN(xb_ld(&hob[1024]) < nx, bar.bar); __builtin_amdgcn_fence(__ATOMIC_ACQUIRE, "agent"); asm volatile("s_waitcnt vmcnt(0)" ::: "memory"); }
            __syncthreads();
            phase_lrufix(ws, lds, bid, G, tid, lane, wave, hob + 1536);
        }
    } SEAM(3);
    if (N_LAUNCHES != 1) { if (IN(4)) REPS(4) { PHASE_VARS phase_lrufix(ws, lds, bid, G, tid, lane, wave); } SEAM(4); }
    if (IN(5)) REPS(5) {
        PHASE_VARS
        pg8::StaticOrder S; S.init(MTOK, DM, DM, G, bid, ws + WS_MIX, ws + WS_WOUT);
        EpiOutProj E{args.in[I_X], (bf16_t*)(ws + WS_X1), (const float*)(ws + WS_MODV), (float*)(ws + WS_SS)};
        pg8::gemm_phase<EpiOutProj, pg8::StaticOrder, false, true>(lds, DM, S, E);
    } SEAM(5);
    if (IN(6)) { PHASE_VARS phase_router(args, ws, lds, bid, G, tid, lane, wave); } SEAM(6);
    if (IN(7)) { PHASE_VARS phase_fill(args, lds, bid, G, tid); } SEAM(7);
    if (IN(8) || IN(9)) {
        PHASE_VARS
        const int* tinfo = (const int*)(ws + WS_TILE); LAS int* tl = (LAS int*)(lds + LDS_TILE_OFF);
        const int ntl = tinfo[0]; for (int t = tid; t < ntl; t += NWAVES * 64) tl[t] = tinfo[16 + t];
        __syncthreads();
    }
    if (IN(8)) REPS(8) {
        PHASE_VARS
        const int* tinfo = (const int*)(ws + WS_TILE);
        MoeOrder S{bid, 3, (G >> 3) >> 3, tinfo[0], (const LAS int*)(lds + LDS_TILE_OFF), (const int*)(ws + WS_ROWTOK), (const char*)(ws + WS_XN), 0, (const char*)(ws + WS_W1), (size_t)2048 * DM, (size_t)256 * DM, args.in[I_B1], 2048, 128, nullptr};
        EpiMoe1 E{(unsigned char*)(ws + WS_ACT), args.in[I_B1]};
        pg8::gemm_phase<EpiMoe1, MoeOrder, true, true, true>(lds, DM / 2, S, E, (LAS int*)(lds + LDS_ROWL_OFF), (LAS float*)(lds + LDS_AUX_OFF));
    } SEAM(8);
    if (IN(9)) REPS(9) {
        PHASE_VARS
        const int* tinfo = (const int*)(ws + WS_TILE);
        MoeOrder S{bid, 2, (G >> 3) >> 2, tinfo[0], (const LAS int*)(lds + LDS_TILE_OFF), (const int*)(ws + WS_ROWTOK), (const char*)(ws + WS_ACT), (size_t)256 * DFF, (const char*)(ws + WS_W2), (size_t)DM * DFF, (size_t)256 * DFF, args.in[I_B2], 1024, 256, (const float*)(ws + WS_ROWG)};
        EpiMoe2 E{(unsigned char*)(ws + WS_Y), args.in[I_B2], (const float*)(ws + WS_ROWG)};
        pg8::gemm_phase<EpiMoe2, MoeOrder, false, true, true>(lds, DFF / 2, S, E, nullptr, (LAS float*)(lds + LDS_AUX_OFF));
    } SEAM(9);
    if (IN(10)) { PHASE_VARS phase_combine(args, bid, G, lane, wave);
#if defined(PROBE_COMBINE)
        __syncthreads(); phase_combine(args, bid, G, lane, wave, 0.0f);
#endif
    }
#undef IN
#undef SEAM
#undef PHASE_VARS
}

extern "C" void kernel_launch(void* const* d_in, const int* in_sizes, int n_in, void* d_out, int out_size, void* d_ws, size_t ws_size, hipStream_t stream) {
    static int grid = 0;
    if (grid == 0) {
        if (n_in != 28 || in_sizes[0] != MTOK * DM || out_size != MTOK * DM || ws_size < WS_END) { fprintf(stderr, "kernel_launch: unexpected shapes (n_in %d, ws %zu)\n", n_in, ws_size); grid = -1; return; }
        int dev = 0, cus = 0, per_cu = 0;
        if (hipGetDevice(&dev) != hipSuccess || hipDeviceGetAttribute(&cus, hipDeviceAttributeMultiprocessorCount, dev) != hipSuccess) { grid = -1; return; }
        if (hipFuncSetAttribute((const void*)fwd_kernel, hipFuncAttributeMaxDynamicSharedMemorySize, LDS_BYTES) != hipSuccess) { fprintf(stderr, "kernel_launch: hipFuncSetAttribute failed\n"); grid = -1; return; }
        if (hipOccupancyMaxActiveBlocksPerMultiprocessor(&per_cu, (const void*)fwd_kernel, NWAVES * 64, LDS_BYTES) != hipSuccess || per_cu < 1) fprintf(stderr, "kernel_launch: occupancy query reports %d\n", per_cu);
        (void)hipGetLastError();
        grid = cus;
    }
    if (grid < 0) return;
    if (hipMemsetAsync((char*)d_ws + WS_CTL, 0, CTL_ZERO_BYTES, stream) != hipSuccess) return;
    Args a{};
    for (int i = 0; i < 28; ++i) a.in[i] = (const float*)d_in[i];
    a.out = (float*)d_out; a.ws = (unsigned char*)d_ws;
    for (int li = 0; li < N_LAUNCHES; ++li) {
        a.ph_lo = (N_LAUNCHES == 1) ? 0 : li; a.ph_hi = (N_LAUNCHES == 1) ? NPHASE : li + 1;
        hipLaunchKernelGGL(fwd_kernel, dim3(grid), dim3(NWAVES * 64), LDS_BYTES, stream, a);
    }
}
```
